# Optimizing an MI355X kernel written in HIP

```python
import jax, jax.numpy as jnp
from jax import lax
import numpy as np

D_MODEL = 1024
BATCH = 8
SEQ = 2048
DEPTH = 2

HEAD_DIM = 64
N_HEADS_A = D_MODEL // HEAD_DIM
WIDTH_A = N_HEADS_A * HEAD_DIM
N_Q_HEADS_B = D_MODEL // HEAD_DIM
N_KV_HEADS_B = 4
GROUP_B = N_Q_HEADS_B // N_KV_HEADS_B
WIDTH_B = N_Q_HEADS_B * HEAD_DIM
KV_WIDTH_B = N_KV_HEADS_B * HEAD_DIM
WINDOW = 128
Q_BLOCK = 128
ROT_DIM = HEAD_DIM // 4
ROPE_THETA = 500000.0
EPS = 1e-6
N_A_LAYERS = DEPTH // 2
N_B_LAYERS = DEPTH - N_A_LAYERS

kernel_name = "yoco_fox_swa_sink_hybrid"


def rmsnorm(x, g):
    xf = x.astype(jnp.float32)
    y = xf * lax.rsqrt(jnp.mean(xf * xf, axis=-1, keepdims=True) + EPS)
    return (y * g.astype(jnp.float32)).astype(x.dtype)


def partial_rope(x, positions):
    x_rot, x_pass = x[..., :ROT_DIM], x[..., ROT_DIM:]
    half = ROT_DIM // 2
    inv_freq = jnp.power(jnp.float32(ROPE_THETA), -jnp.arange(0, ROT_DIM, 2, dtype=jnp.float32) / ROT_DIM)
    ang = positions.astype(jnp.float32)[:, None] * inv_freq[None, :]
    cos = jnp.cos(ang)[None, :, None, :]
    sin = jnp.sin(ang)[None, :, None, :]
    xr = x_rot.astype(jnp.float32)
    x1, x2 = xr[..., :half], xr[..., half:]
    rot = jnp.concatenate([x1 * cos - x2 * sin, x1 * sin + x2 * cos], axis=-1)
    return jnp.concatenate([rot.astype(x.dtype), x_pass], axis=-1)


def fox_attention(q, k, v, log_f):
    b, s, h, d = q.shape
    nb = s // Q_BLOCK
    scale = HEAD_DIM ** -0.5
    c = jnp.cumsum(log_f, axis=1)
    c_k = jnp.transpose(c, (0, 2, 1))
    q_blocks = jnp.moveaxis(q.reshape(b, nb, Q_BLOCK, h, d), 1, 0)
    c_blocks = jnp.moveaxis(c_k.reshape(b, h, nb, Q_BLOCK), 2, 0)
    k_pos = jnp.arange(s)

    def block(args):
        idx, qi, ci = args
        logits = jnp.einsum('bqhd,bkhd->bhqk', qi, k, preferred_element_type=jnp.float32) * scale
        logits = logits + ci[..., :, None] - c_k[..., None, :]
        q_pos = idx * Q_BLOCK + jnp.arange(Q_BLOCK)
        causal = k_pos[None, :] <= q_pos[:, None]
        logits = jnp.where(causal, logits, -jnp.inf)
        p = jax.nn.softmax(logits, axis=-1)
        return jnp.einsum('bhqk,bkhd->bqhd', p.astype(v.dtype), v)

    out = lax.map(block, (jnp.arange(nb), q_blocks, c_blocks))
    return jnp.moveaxis(out, 0, 1).reshape(b, s, h, d)


def swa_sink_attention(q, k, v, sinks):
    b, s, hq, d = q.shape
    hkv = k.shape[2]
    g = hq // hkv
    nb = s // WINDOW
    scale = HEAD_DIM ** -0.5
    qb = q.reshape(b, nb, WINDOW, hkv, g, d)
    pad = ((0, 0), (WINDOW, 0), (0, 0), (0, 0))
    kb = jnp.pad(k, pad).reshape(b, nb + 1, WINDOW, hkv, d)
    vb = jnp.pad(v, pad).reshape(b, nb + 1, WINDOW, hkv, d)
    k_band = jnp.concatenate([kb[:, :-1], kb[:, 1:]], axis=2)
    v_band = jnp.concatenate([vb[:, :-1], vb[:, 1:]], axis=2)
    logits = jnp.einsum('bnqhgd,bnkhd->bnhgqk', qb, k_band, preferred_element_type=jnp.float32) * scale
    diff = (jnp.arange(WINDOW)[:, None] + WINDOW) - jnp.arange(2 * WINDOW)[None, :]
    in_window = (diff >= 0) & (diff < WINDOW)
    k_abs = jnp.arange(nb)[:, None] * WINDOW + jnp.arange(2 * WINDOW)[None, :] - WINDOW
    valid = in_window[None] & (k_abs >= 0)[:, None, :]
    logits = jnp.where(valid[None, :, None, None], logits, -jnp.inf)
    sink = jnp.broadcast_to(sinks.astype(jnp.float32).reshape(1, 1, hkv, g, 1, 1), logits.shape[:-1] + (1,))
    probs = jax.nn.softmax(jnp.concatenate([logits, sink], axis=-1), axis=-1)[..., :-1]
    out = jnp.einsum('bnhgqk,bnkhd->bnqhgd', probs.astype(v.dtype), v_band)
    return out.reshape(b, s, hq, d)


def setup_inputs(seed: int = 0) -> dict:
    key = jax.random.key(seed)
    ks = jax.random.split(key, 20)
    f32 = jnp.float32
    in_a = 3 * WIDTH_A + N_HEADS_A + WIDTH_A
    in_b = WIDTH_B + WIDTH_B
    return {
        "x": jax.random.normal(ks[0], (BATCH, SEQ, D_MODEL), f32),
        "positions": jnp.arange(SEQ, dtype=jnp.int32),
        "norm_a_g": 1.0 + 0.02 * jax.random.normal(ks[1], (N_A_LAYERS, D_MODEL), f32),
        "w_in_a": jax.random.normal(ks[2], (N_A_LAYERS, D_MODEL, in_a), f32) * D_MODEL ** -0.5,
        "b_forget": 3.0 + 0.1 * jax.random.normal(ks[3], (N_A_LAYERS, N_HEADS_A), f32),
        "qnorm_a_g": 1.0 + 0.02 * jax.random.normal(ks[4], (N_A_LAYERS, HEAD_DIM), f32),
        "knorm_a_g": 1.0 + 0.02 * jax.random.normal(ks[5], (N_A_LAYERS, HEAD_DIM), f32),
        "w_out_a": jax.random.normal(ks[6], (N_A_LAYERS, WIDTH_A, D_MODEL), f32) * WIDTH_A ** -0.5,
        "kv_norm_g": 1.0 + 0.02 * jax.random.normal(ks[7], (D_MODEL,), f32),
        "w_kv": jax.random.normal(ks[8], (D_MODEL, 2 * KV_WIDTH_B), f32) * D_MODEL ** -0.5,
        "knorm_b_g": 1.0 + 0.02 * jax.random.normal(ks[9], (HEAD_DIM,), f32),
        "norm_b_g": 1.0 + 0.02 * jax.random.normal(ks[10], (N_B_LAYERS, D_MODEL), f32),
        "w_in_b": jax.random.normal(ks[11], (N_B_LAYERS, D_MODEL, in_b), f32) * D_MODEL ** -0.5,
        "qnorm_b_g": 1.0 + 0.02 * jax.random.normal(ks[12], (N_B_LAYERS, HEAD_DIM), f32),
        "sinks": 0.5 * jax.random.normal(ks[13], (N_B_LAYERS, N_Q_HEADS_B), f32),
        "w_out_b": jax.random.normal(ks[14], (N_B_LAYERS, WIDTH_B, D_MODEL), f32) * WIDTH_B ** -0.5,
    }


def reference(x, positions, norm_a_g, w_in_a, b_forget, qnorm_a_g, knorm_a_g, w_out_a,
              kv_norm_g, w_kv, knorm_b_g, norm_b_g, w_in_b, qnorm_b_g, sinks, w_out_b):
    b, s, _ = x.shape
    h = x
    k_shared = None
    v_shared = None
    for layer in range(DEPTH):
        if layer < N_A_LAYERS:
            i = layer
            u = rmsnorm(h, norm_a_g[i])
            proj = u @ w_in_a[i]
            q, k, v, f_logit, gate = jnp.split(
                proj, [WIDTH_A, 2 * WIDTH_A, 3 * WIDTH_A, 3 * WIDTH_A + N_HEADS_A], axis=-1)
            q = rmsnorm(q.reshape(b, s, N_HEADS_A, HEAD_DIM), qnorm_a_g[i])
            k = rmsnorm(k.reshape(b, s, N_HEADS_A, HEAD_DIM), knorm_a_g[i])
            v = v.reshape(b, s, N_HEADS_A, HEAD_DIM)
            log_f = jax.nn.log_sigmoid((f_logit + b_forget[i]).astype(jnp.float32))
            o = fox_attention(q, k, v, log_f).reshape(b, s, WIDTH_A)
            h = h + (o * jax.nn.silu(gate)) @ w_out_a[i]
        else:
            if layer == N_A_LAYERS:
                u_kv = rmsnorm(h, kv_norm_g)
                k_s, v_s = jnp.split(u_kv @ w_kv, [KV_WIDTH_B], axis=-1)
                k_shared = partial_rope(rmsnorm(k_s.reshape(b, s, N_KV_HEADS_B, HEAD_DIM), knorm_b_g), positions)
                v_shared = v_s.reshape(b, s, N_KV_HEADS_B, HEAD_DIM)
            j = layer - N_A_LAYERS
            u = rmsnorm(h, norm_b_g[j])
            q, gate = jnp.split(u @ w_in_b[j], [WIDTH_B], axis=-1)
            q = partial_rope(rmsnorm(q.reshape(b, s, N_Q_HEADS_B, HEAD_DIM), qnorm_b_g[j]), positions)
            o = swa_sink_attention(q, k_shared, v_shared, sinks[j]).reshape(b, s, WIDTH_B)
            h = h + (o * jax.nn.silu(gate)) @ w_out_b[j]
    return h
```

```cpp
#define MK_CUTS 0
#define NAIVE_MASK 0
#include <hip/hip_runtime.h>
#include <stdint.h>
#include <cstdio>
#include <cmath>

typedef unsigned short bf16_t;
typedef short bf16x8 __attribute__((ext_vector_type(8)));
typedef float f32x4 __attribute__((ext_vector_type(4)));

constexpr int BATCH = 8, SEQ = 2048, DM = 1024, NH = 16, HD = 64, M = BATCH * SEQ;
constexpr int KVW = 256;
constexpr int NA = 4096;
constexpr int NB = 2560;
constexpr int WINA = 4112;
constexpr float EPS = 1e-6f;
constexpr float LOG2E = 1.4426950408889634f;
constexpr float C2 = 0.125f * LOG2E;

constexpr size_t MiB = 1u << 20;
constexpr size_t WS_CTL = 0;
constexpr size_t WS_WTA = 2 * MiB;
constexpr size_t WS_WTOA = 10 * MiB;
constexpr size_t WS_WTB = 12 * MiB;
constexpr size_t WS_WTOB = 17 * MiB;
constexpr size_t WS_WF = 19 * MiB;
constexpr size_t WS_ROPE = 19 * MiB + 65536;
constexpr size_t WS_RS0 = 20 * MiB;
constexpr size_t WS_SS1 = 20 * MiB + 65536;
constexpr size_t WS_LF = 21 * MiB;
constexpr size_t WS_CK2 = 22 * MiB;
constexpr size_t WS_XB = 24 * MiB;
constexpr size_t WS_Q0 = 56 * MiB;
constexpr size_t WS_K0 = 88 * MiB;
constexpr size_t WS_V0 = 120 * MiB;
constexpr size_t WS_G0 = 152 * MiB;
constexpr size_t WS_END = 184 * MiB;

struct P {
    const float* x; const int* positions; const float* norm_a_g; const float* w_in_a; const float* b_forget; const float* qnorm_a_g; const float* knorm_a_g;
    const float* w_out_a; const float* kv_norm_g; const float* w_kv; const float* knorm_b_g; const float* norm_b_g; const float* w_in_b; const float* qnorm_b_g;
    const float* sinks; const float* w_out_b;
    float* out; unsigned char* ws;
    double invf[8];
};

__device__ __forceinline__ unsigned f2bf(float f) { unsigned u = __builtin_bit_cast(unsigned, f); return (u + 0x7fffu + ((u >> 16) & 1u)) >> 16; }
__device__ __forceinline__ float bf2f(unsigned short h) { return __builtin_bit_cast(float, (unsigned)h << 16); }
__device__ __forceinline__ float wave_sum(float v) {
#pragma unroll
    for (int o = 1; o < 64; o <<= 1) v += __shfl_xor(v, o);
    return v;
}
__device__ __forceinline__ float silu_f(float v) { return v / (1.0f + __expf(-v)); }

__device__ __forceinline__ void sincos_d(double a, double& s, double& c) {
    const double TWO_PI = 6.283185307179586476925, INV = 0.15915494309189533577;
    const double n = rint(a * INV);
    const double r = fma(-n, TWO_PI, a), z = r * r;
    double ps = 1.0 / 8841761993739701954543616000000.0, pc = 1.0 / 304888344611713860501504000000.0;
    const double cs[14] = { -1.0 / 10888869450418352160768000000.0, 1.0 / 15511210043330985984000000.0, -1.0 / 25852016738884976640000.0, 1.0 / 51090942171709440000.0, -1.0 / 121645100408832000.0, 1.0 / 355687428096000.0, -1.0 / 1307674368000.0, 1.0 / 6227020800.0, -1.0 / 39916800.0, 1.0 / 362880.0, -1.0 / 5040.0, 1.0 / 120.0, -1.0 / 6.0, 1.0 / 1.0 };
    const double cc[14] = { -1.0 / 403291461126605635584000000.0, 1.0 / 620448401733239439360000.0, -1.0 / 1124000727777607680000.0, 1.0 / 2432902008176640000.0, -1.0 / 6402373705728000.0, 1.0 / 20922789888000.0, -1.0 / 87178291200.0, 1.0 / 479001600.0, -1.0 / 3628800.0, 1.0 / 40320.0, -1.0 / 720.0, 1.0 / 24.0, -1.0 / 2.0, 1.0 / 1.0 };
#pragma unroll
    for (int k = 0; k < 14; ++k) { ps = fma(ps, z, cs[k]); pc = fma(pc, z, cc[k]); }
    s = ps * r; c = pc;
}
__global__ void __launch_bounds__(256) k_prep_weights(P p) {
    bf16_t* WTA = (bf16_t*)(p.ws + WS_WTA); bf16_t* WTOA = (bf16_t*)(p.ws + WS_WTOA); bf16_t* WTB = (bf16_t*)(p.ws + WS_WTB); bf16_t* WTOB = (bf16_t*)(p.ws + WS_WTOB);
    float* WF = (float*)(p.ws + WS_WF); float* ROPE = (float*)(p.ws + WS_ROPE);
    const size_t n0 = (size_t)NA * 1024, n1 = n0 + 16 * 1024, n2 = n1 + (size_t)1024 * 1024, n3 = n2 + (size_t)NB * 1024, n4 = n3 + (size_t)1024 * 1024, n5 = n4 + 2048 * 8;
    for (size_t i = (size_t)blockIdx.x * 256 + threadIdx.x; i < n5; i += (size_t)gridDim.x * 256) {
        if (i < n0) { const int n = (int)(i >> 10), k = (int)(i & 1023); const int col = n < 3072 ? n : n + 16; WTA[i] = (bf16_t)f2bf(p.norm_a_g[k] * p.w_in_a[(size_t)k * WINA + col]); }
        else if (i < n1) { const size_t j = i - n0; const int h = (int)(j >> 10), k = (int)(j & 1023); WF[j] = p.norm_a_g[k] * p.w_in_a[(size_t)k * WINA + 3072 + h]; }
        else if (i < n2) { const size_t j = i - n1; const int n = (int)(j >> 10), k = (int)(j & 1023); WTOA[j] = (bf16_t)f2bf(p.w_out_a[(size_t)k * 1024 + n]); }
        else if (i < n3) { const size_t j = i - n2; const int n = (int)(j >> 10), k = (int)(j & 1023);
            const float v = n < 512 ? p.kv_norm_g[k] * p.w_kv[(size_t)k * 512 + n] : p.norm_b_g[k] * p.w_in_b[(size_t)k * 2048 + (n - 512)]; WTB[j] = (bf16_t)f2bf(v); }
        else if (i < n4) { const size_t j = i - n3; const int n = (int)(j >> 10), k = (int)(j & 1023); WTOB[j] = (bf16_t)f2bf(p.w_out_b[(size_t)k * 1024 + n]); }
        else { const size_t j = i - n4; const int s = (int)(j >> 3), f = (int)(j & 7); double sn, cs; sincos_d((double)p.positions[s] * p.invf[f], sn, cs); ROPE[j] = (float)cs; ROPE[2048 * 8 + j] = (float)sn; }
    }
}

__global__ void __launch_bounds__(256) k_prep_x(P p) {
    const int wave = threadIdx.x >> 6, lane = threadIdx.x & 63, m = blockIdx.x * 4 + wave;
    const float* WF = (const float*)(p.ws + WS_WF); bf16_t* XB = (bf16_t*)(p.ws + WS_XB); float* RS0 = (float*)(p.ws + WS_RS0); float* LF = (float*)(p.ws + WS_LF);
    const f32x4* xr = (const f32x4*)(p.x + (size_t)m * 1024);
    f32x4 v[4]; float ss = 0.f;
#pragma unroll
    for (int j = 0; j < 4; ++j) { v[j] = xr[lane + 64 * j]; ss += (v[j].x * v[j].x + v[j].y * v[j].y) + (v[j].z * v[j].z + v[j].w * v[j].w); }
    ss = wave_sum(ss);
    const float rstd = 1.0f / sqrtf(ss * (1.0f / 1024.0f) + EPS);
#pragma unroll
    for (int j = 0; j < 4; ++j) { uint2 o; o.x = f2bf(v[j].x) | (f2bf(v[j].y) << 16); o.y = f2bf(v[j].z) | (f2bf(v[j].w) << 16); *(uint2*)(XB + (size_t)m * 1024 + 4 * (lane + 64 * j)) = o; }
    float mine = 0.f;
#pragma unroll 1
    for (int h = 0; h < 16; ++h) {
        const f32x4* wr = (const f32x4*)(WF + h * 1024); float a = 0.f;
#pragma unroll
        for (int j = 0; j < 4; ++j) { const f32x4 w = wr[lane + 64 * j]; a += (v[j].x * w.x + v[j].y * w.y) + (v[j].z * w.z + v[j].w * w.w); }
        a = wave_sum(a); if (lane == h) mine = a;
    }
    if (lane < 16) { const float z = mine * rstd + p.b_forget[lane]; const float lf = fminf(z, 0.f) - log1pf(expf(-fabsf(z))); const int b = m / SEQ, s = m % SEQ; LF[((size_t)b * 16 + lane) * SEQ + s] = lf; }
    if (lane == 0) RS0[m] = rstd;
}

__global__ void __launch_bounds__(256) k_scan(P p) {
    __shared__ double wsum[4];
    const float* LF = (const float*)(p.ws + WS_LF); float* CK2 = (float*)(p.ws + WS_CK2);
    const int bh = blockIdx.x, tid = threadIdx.x, lane = tid & 63, wave = tid >> 6;
    const float* src = LF + (size_t)bh * SEQ + tid * 8;
    double loc[8]; double run = 0.0;
#pragma unroll
    for (int i = 0; i < 8; ++i) { run += (double)src[i]; loc[i] = run; }
    double incl = run;
#pragma unroll
    for (int o = 1; o < 64; o <<= 1) { const double t = __shfl_up(incl, o); if (lane >= o) incl += t; }
    if (lane == 63) wsum[wave] = incl;
    __syncthreads();
    double base = 0.0;
    for (int w = 0; w < wave; ++w) base += wsum[w];
    const double excl = base + incl - run;
#pragma unroll
    for (int i = 0; i < 8; ++i) CK2[(size_t)bh * SEQ + tid * 8 + i] = (float)((excl + loc[i]) * 1.4426950408889634);
}

template <int EPI> __global__ void __launch_bounds__(256) k_gemm_naive(P p) {
    const int wave = threadIdx.x >> 6, lane = threadIdx.x & 63, fr = lane & 15, fq = lane >> 4;
    const int row0 = 64 * blockIdx.y + 16 * wave, col0 = 64 * blockIdx.x, hb = blockIdx.x;
    const bf16_t* Ab = (const bf16_t*)(p.ws + (EPI == 0 ? WS_XB : EPI == 1 ? WS_Q0 : EPI == 2 ? WS_XB : WS_K0));
    const bf16_t* Bb = (const bf16_t*)(p.ws + (EPI == 0 ? WS_WTA : EPI == 1 ? WS_WTOA : EPI == 2 ? WS_WTB : WS_WTOB));
    const bf16_t* A = Ab + (size_t)(row0 + fr) * 1024 + 8 * fq;
    const bf16_t* B = Bb + (size_t)(col0 + fr) * 1024 + 8 * fq;
    f32x4 acc[4];
#pragma unroll
    for (int j = 0; j < 4; ++j) acc[j] = (f32x4){0.f, 0.f, 0.f, 0.f};
#pragma unroll 2
    for (int k0 = 0; k0 < 1024; k0 += 32) {
        const bf16x8 a = *(const bf16x8*)(A + k0);
#pragma unroll
        for (int j = 0; j < 4; ++j) { const bf16x8 b = *(const bf16x8*)(B + (size_t)16 * j * 1024 + k0); acc[j] = __builtin_amdgcn_mfma_f32_16x16x32_bf16(a, b, acc[j], 0, 0, 0); }
    }
    const float* ROPE = (const float*)(p.ws + WS_ROPE);
#pragma unroll
    for (int i = 0; i < 4; ++i) {
        const int r = row0 + 4 * fq + i;
        float v[4];
#pragma unroll
        for (int j = 0; j < 4; ++j) v[j] = acc[j][i];
        if (EPI == 0) {
            const float rs = ((const float*)(p.ws + WS_RS0))[r];
#pragma unroll
            for (int j = 0; j < 4; ++j) v[j] *= rs;
            if (hb < 32) {
                float ss = (v[0] * v[0] + v[1] * v[1]) + (v[2] * v[2] + v[3] * v[3]);
                ss += __shfl_xor(ss, 1); ss += __shfl_xor(ss, 2); ss += __shfl_xor(ss, 4); ss += __shfl_xor(ss, 8);
                const float hr = 1.0f / sqrtf(ss * (1.0f / 64.0f) + EPS);
                const float* g = hb < 16 ? p.qnorm_a_g : p.knorm_a_g; const float sc = hb < 16 ? C2 : 1.0f;
                bf16_t* dst = (bf16_t*)(p.ws + (hb < 16 ? WS_Q0 : WS_K0)) + (size_t)r * 1024 + (hb & 15) * 64;
#pragma unroll
                for (int j = 0; j < 4; ++j) dst[16 * j + fr] = (bf16_t)f2bf(v[j] * hr * g[16 * j + fr] * sc);
            } else if (hb < 48) {
                bf16_t* dst = (bf16_t*)(p.ws + WS_V0) + (size_t)r * 1024 + (hb - 32) * 64;
#pragma unroll
                for (int j = 0; j < 4; ++j) dst[16 * j + fr] = (bf16_t)f2bf(v[j]);
            } else {
                bf16_t* dst = (bf16_t*)(p.ws + WS_G0) + (size_t)r * 1024 + (hb - 48) * 64;
#pragma unroll
                for (int j = 0; j < 4; ++j) dst[16 * j + fr] = (bf16_t)f2bf(silu_f(v[j]));
            }
        } else if (EPI == 1) {
            bf16_t* HB = (bf16_t*)(p.ws + WS_XB);
#pragma unroll
            for (int j = 0; j < 4; ++j) { const size_t o = (size_t)r * 1024 + col0 + 16 * j + fr; const float h1 = p.x[o] + v[j]; p.out[o] = h1; HB[o] = (bf16_t)f2bf(h1); }
        } else if (EPI == 2) {
            const f32x4 pp = *(const f32x4*)((const float*)(p.ws + WS_SS1) + (size_t)r * 4);
            const float rs = 1.0f / sqrtf(((pp.x + pp.y) + (pp.z + pp.w)) * (1.0f / 1024.0f) + EPS);
#pragma unroll
            for (int j = 0; j < 4; ++j) v[j] *= rs;
            const bool isk = hb < 4, isq = hb >= 8 && hb < 24;
            if (isk || isq) {
                float ss = (v[0] * v[0] + v[1] * v[1]) + (v[2] * v[2] + v[3] * v[3]);
                ss += __shfl_xor(ss, 1); ss += __shfl_xor(ss, 2); ss += __shfl_xor(ss, 4); ss += __shfl_xor(ss, 8);
                const float hr = 1.0f / sqrtf(ss * (1.0f / 64.0f) + EPS);
                const float* g = isk ? p.knorm_b_g : p.qnorm_b_g; const float sc = isk ? 1.0f : C2;
                float y[4];
#pragma unroll
                for (int j = 0; j < 4; ++j) y[j] = v[j] * hr * g[16 * j + fr];
                { const float partner = __shfl_xor(y[0], 8); const int s = r % SEQ, f = fr & 7; const float cs = ROPE[s * 8 + f], sn = ROPE[2048 * 8 + s * 8 + f];
                  y[0] = fr < 8 ? y[0] * cs - partner * sn : partner * sn + y[0] * cs; }
                bf16_t* dst = isk ? (bf16_t*)(p.ws + WS_G0) + (size_t)r * KVW + hb * 64 : (bf16_t*)(p.ws + WS_K0) + (size_t)r * 1024 + (hb - 8) * 64;
#pragma unroll
                for (int j = 0; j < 4; ++j) dst[16 * j + fr] = (bf16_t)f2bf(y[j] * sc);
            } else if (hb < 8) {
                bf16_t* dst = (bf16_t*)(p.ws + WS_G0 + 8 * MiB) + (size_t)r * KVW + (hb - 4) * 64;
#pragma unroll
                for (int j = 0; j < 4; ++j) dst[16 * j + fr] = (bf16_t)f2bf(v[j]);
            } else {
                bf16_t* dst = (bf16_t*)(p.ws + WS_V0) + (size_t)r * 1024 + (hb - 24) * 64;
#pragma unroll
                for (int j = 0; j < 4; ++j) dst[16 * j + fr] = (bf16_t)f2bf(silu_f(v[j]));
            }
        } else {
#pragma unroll
            for (int j = 0; j < 4; ++j) { const size_t o = (size_t)r * 1024 + col0 + 16 * j + fr; p.out[o] = p.out[o] + v[j]; }
        }
    }
}

__global__ void __launch_bounds__(256) k_rowstat(P p) {
    const int wave = threadIdx.x >> 6, lane = threadIdx.x & 63, m = blockIdx.x * 4 + wave;
    const f32x4* xr = (const f32x4*)(p.out + (size_t)m * 1024); float ss = 0.f;
#pragma unroll
    for (int j = 0; j < 4; ++j) { const f32x4 v = xr[lane + 64 * j]; ss += (v.x * v.x + v.y * v.y) + (v.z * v.z + v.w * v.w); }
    ss = wave_sum(ss);
    if (lane == 0) *(f32x4*)((float*)(p.ws + WS_SS1) + (size_t)m * 4) = (f32x4){ss, 0.f, 0.f, 0.f};
}

template <int MODE> __global__ void __launch_bounds__(256) k_attn_naive(P p) {
    __shared__ __attribute__((aligned(16))) bf16_t Ks[64 * 64];
    __shared__ __attribute__((aligned(16))) bf16_t Vs[64 * 64];
    __shared__ float cks[64];
    const int t = threadIdx.x, qb = blockIdx.x, bh = blockIdx.y, b = bh >> 4, h = bh & 15;
    const int kvh = MODE ? (h >> 2) : h, kvp = MODE ? KVW : 1024;
    const bf16_t* Q = (const bf16_t*)(p.ws + (MODE ? WS_K0 : WS_Q0)); bf16_t* O = (bf16_t*)(p.ws + (MODE ? WS_K0 : WS_Q0));
    const bf16_t* K = (const bf16_t*)(p.ws + (MODE ? WS_G0 : WS_K0)); const bf16_t* V = (const bf16_t*)(p.ws + (MODE ? WS_G0 + 8 * MiB : WS_V0));
    const bf16_t* G = (const bf16_t*)(p.ws + (MODE ? WS_V0 : WS_G0));
    const float* CK2 = (const float*)(p.ws + WS_CK2);
    const int qrow = qb * 64 + (t >> 2), part = t & 3;
    const size_t qoff = ((size_t)b * SEQ + qrow) * 1024 + h * 64;
    float q[64], o[64];
#pragma unroll
    for (int d = 0; d < 64; d += 8) { const bf16x8 v = *(const bf16x8*)(Q + qoff + d);
#pragma unroll
        for (int e = 0; e < 8; ++e) q[d + e] = bf2f((unsigned short)v[e]); }
#pragma unroll
    for (int d = 0; d < 64; ++d) o[d] = 0.f;
    float l = 0.f;
    const float cq = MODE == 0 ? CK2[(size_t)bh * SEQ + qrow] : 0.f;
    const int kt0 = MODE ? (qb >= 2 ? qb - 2 : 0) : 0;
    for (int kt = kt0; kt <= qb; ++kt) {
        __syncthreads();
        { const int row = t >> 2, cs = (t & 3) * 16; const size_t ko = ((size_t)b * SEQ + kt * 64 + row) * kvp + kvh * 64 + cs;
          *(bf16x8*)(Ks + row * 64 + cs) = *(const bf16x8*)(K + ko); *(bf16x8*)(Ks + row * 64 + cs + 8) = *(const bf16x8*)(K + ko + 8);
          *(bf16x8*)(Vs + row * 64 + cs) = *(const bf16x8*)(V + ko); *(bf16x8*)(Vs + row * 64 + cs + 8) = *(const bf16x8*)(V + ko + 8);
          if (MODE == 0 && t < 64) cks[t] = CK2[(size_t)bh * SEQ + kt * 64 + t]; }
        __syncthreads();
#pragma unroll 1
        for (int kk = 0; kk < 16; ++kk) {
            const int key = part * 16 + kk, kpos = kt * 64 + key;
            float s = 0.f;
#pragma unroll
            for (int d = 0; d < 64; d += 8) { const bf16x8 kv = *(const bf16x8*)(Ks + key * 64 + d);
#pragma unroll
                for (int e = 0; e < 8; ++e) s += q[d + e] * bf2f((unsigned short)kv[e]); }
            if (MODE == 0) s += cq - cks[key];
            const bool valid = kpos <= qrow && (MODE == 0 || kpos > qrow - 128);
            const float pr = valid ? __builtin_amdgcn_exp2f(s) : 0.f;
            l += pr;
#pragma unroll
            for (int d = 0; d < 64; d += 8) { const bf16x8 vv = *(const bf16x8*)(Vs + key * 64 + d);
#pragma unroll
                for (int e = 0; e < 8; ++e) o[d + e] += pr * bf2f((unsigned short)vv[e]); }
        }
    }
    l += __shfl_xor(l, 1); l += __shfl_xor(l, 2);
#pragma unroll
    for (int d = 0; d < 64; ++d) { o[d] += __shfl_xor(o[d], 1); o[d] += __shfl_xor(o[d], 2); }
    if (MODE == 1) l += __builtin_amdgcn_exp2f(p.sinks[h] * LOG2E);
    const float rl = 1.0f / l;
#pragma unroll
    for (int d = 0; d < 64; ++d) if ((d >> 4) == part) O[qoff + d] = (bf16_t)f2bf(o[d] * rl * bf2f(G[qoff + d]));
}

namespace pg8 {
#define PG8_LAS __attribute__((address_space(3)))
typedef unsigned short bf16_t;
typedef short bf16x8 __attribute__((ext_vector_type(8)));
typedef float f32x4 __attribute__((ext_vector_type(4)));
typedef unsigned u32x4 __attribute__((ext_vector_type(4)));
constexpr int BM = 256, BK = 64, HALF = 128, HTB = HALF * BK * 2  , STAGE_BYTES = 8 * HTB, NXCD = 8, WGM = 8;

__host__ __device__ __forceinline__ int lds_byte(int r, int c) { const int st = (r >> 4) * 2 + (c >> 5), rr = r & 15, cc = c & 31, ob = rr * 64 + cc * 2; return st * 1024 + (ob ^ (((ob >> 9) & 1) << 5)); }
__host__ __device__ __forceinline__ void stage_rc(int b, int& R, int& C) { const int st = b / 1024, sb = b % 1024, swz = sb ^ (((sb >> 9) & 1) << 5); R = (st >> 1) * 16 + swz / 64; C = (st & 1) * 32 + (swz % 64) / 2; }
__host__ __device__ __forceinline__ int perm32(int rho) { const int n = rho >> 4, i = rho & 15; return 8 * (i >> 2) + 4 * n + (i & 3); }

struct Unit { int pm, pn; };
struct Gemm { const bf16_t* A; const bf16_t* Bt; int M, N, K; };

struct StaticOrder {
    int nM, nN, nwg, G, c;
    __host__ __device__ void init(int M, int N, int G_, int c_) { nM = M / BM; nN = N / BM; nwg = nM * nN; G = G_; c = c_; }
    __host__ __device__ bool next(int i, Unit& u) const {
        const long L = (long)i * G + c; if (L >= nwg) return false;
        int wgid = (int)L; { const int q = nwg / NXCD, r = nwg % NXCD, xcd = wgid % NXCD, off = wgid / NXCD; wgid = (xcd < r ? xcd * (q + 1) : r * (q + 1) + (xcd - r) * q) + off; }
        const int nig = WGM * nN, gid = wgid / nig, fm = gid * WGM, gsz = (nM - fm) < WGM ? (nM - fm) : WGM;
        u.pm = fm + ((wgid % nig) % gsz); u.pn = (wgid % nig) / gsz; return true;
    }
    __device__ __forceinline__ void a_ready(const Unit&) const {}
    __device__ __forceinline__ void done(const Unit&) const {}
};


typedef float f32x2_t __attribute__((ext_vector_type(2))); typedef __bf16 bf16x2_t __attribute__((ext_vector_type(2)));
__device__ __forceinline__ unsigned cvtpk(float lo, float hi) { f32x2_t v = {lo, hi}; bf16x2_t b = __builtin_convertvector(v, bf16x2_t); return __builtin_bit_cast(unsigned, b); }
__device__ __forceinline__ float silu1(float v) { return v * __builtin_amdgcn_rcpf(1.0f + __builtin_amdgcn_exp2f(-1.4426950408889634f * v)); }
constexpr float EPI_EPS = 1e-6f, EPI_C2 = 0.125f * 1.4426950408889634f;

template <int LAYER> struct EpiProj {
    static constexpr bool PERM = true, AFTER_DRAIN = false;
    const float* rs;
    const float* gq; const float* gk; const float* rope;
    bf16_t* base;
    PG8_LAS float* xch;
    __device__ __forceinline__ void operator()(f32x4 (&acc)[2][2][4][2], const Unit& u, int wr, int wc, int fr, int fq) const {
        int kind, tcol, pitch; size_t doff;
        constexpr size_t Mi = (size_t)1 << 20;
        if (LAYER == 0) { kind = u.pn >> 2; tcol = (u.pn & 3) * 256; pitch = 1024; doff = (size_t)kind * (16 * Mi); }
        else { if (u.pn == 0) { kind = 1; tcol = 0; pitch = 256; doff = 32 * Mi; } else if (u.pn == 1) { kind = 2; tcol = 0; pitch = 256; doff = 36 * Mi; }
               else if (u.pn < 6) { kind = 0; tcol = (u.pn - 2) * 256; pitch = 1024; doff = 0; } else { kind = 3; tcol = (u.pn - 6) * 256; pitch = 1024; doff = 16 * Mi; } }
        bf16_t* dst = base + doff;
        const int rowl0 = wr * 64 + fr, row0 = u.pm * BM + rowl0;
#pragma unroll
        for (int ai = 0; ai < 2; ++ai)
#pragma unroll
            for (int m = 0; m < 4; ++m) { const int r = row0 + ai * HALF + m * 16; float rsv;
                if (LAYER == 0) rsv = rs[r]; else { const f32x4 pp = *(const f32x4*)(rs + (size_t)r * 4); rsv = 1.0f / sqrtf(((pp[0] + pp[1]) + (pp[2] + pp[3])) * (1.0f / 1024.0f) + EPI_EPS); }
#pragma unroll
                for (int bj = 0; bj < 2; ++bj) { acc[ai][bj][m][0] *= rsv; acc[ai][bj][m][1] *= rsv; } }
        bf16_t* dcol = dst + tcol + wc * 32 + 8 * fq;
        if (kind <= 1) {
#pragma unroll
            for (int ai = 0; ai < 2; ++ai)
#pragma unroll
                for (int m = 0; m < 4; ++m)
#pragma unroll
                    for (int bj = 0; bj < 2; ++bj) { const f32x4 a = acc[ai][bj][m][0], b = acc[ai][bj][m][1];
                        float ss = ((a[0] * a[0] + a[1] * a[1]) + (a[2] * a[2] + a[3] * a[3])) + ((b[0] * b[0] + b[1] * b[1]) + (b[2] * b[2] + b[3] * b[3]));
                        ss += __shfl_xor(ss, 16); ss += __shfl_xor(ss, 32);
                        if (fq == 0) xch[((ai * HALF + rowl0 + m * 16) * 2 + bj) * 4 + wc] = ss; }
            asm volatile("s_waitcnt lgkmcnt(0)" ::: "memory"); __builtin_amdgcn_s_barrier(); asm volatile("" ::: "memory");
            const float* g = kind == 0 ? gq : gk; const float sc = kind == 0 ? EPI_C2 : 1.0f;
            const int d0 = 32 * (wc & 1) + 8 * fq;
            const f32x4 g0 = *(const f32x4*)(g + d0) * sc, g1 = *(const f32x4*)(g + d0 + 4) * sc;
            const bool rot = LAYER == 1 && (wc & 1) == 0;
#pragma unroll
            for (int ai = 0; ai < 2; ++ai)
#pragma unroll
                for (int m = 0; m < 4; ++m) { const int r = row0 + ai * HALF + m * 16;
                    f32x4 cs0 = {}, cs1 = {}, sn0 = {}, sn1 = {};
                    if (rot) { const float* rp = rope + (size_t)(r & 2047) * 8; cs0 = *(const f32x4*)rp; cs1 = *(const f32x4*)(rp + 4); sn0 = *(const f32x4*)(rp + 16384); sn1 = *(const f32x4*)(rp + 16384 + 4); }
#pragma unroll
                    for (int bj = 0; bj < 2; ++bj) { const f32x2_t pr = *(const PG8_LAS f32x2_t*)(xch + ((ai * HALF + rowl0 + m * 16) * 2 + bj) * 4 + (wc & 2)); const float tot = pr[0] + pr[1];
                        const float hr = 1.0f / sqrtf(tot * (1.0f / 64.0f) + EPI_EPS);
                        f32x4 y0 = acc[ai][bj][m][0] * hr * g0, y1 = acc[ai][bj][m][1] * hr * g1;
                        if (rot) { f32x4 p0, p1;
#pragma unroll
                            for (int i = 0; i < 4; ++i) { p0[i] = __shfl_xor(y0[i], 16); p1[i] = __shfl_xor(y1[i], 16); }
                            if (fq == 0) { y0 = y0 * cs0 - p0 * sn0; y1 = y1 * cs1 - p1 * sn1; }
                            else if (fq == 1) { y0 = p0 * sn0 + y0 * cs0; y1 = p1 * sn1 + y1 * cs1; } }
                        u32x4 w; w.x = cvtpk(y0[0], y0[1]); w.y = cvtpk(y0[2], y0[3]); w.z = cvtpk(y1[0], y1[1]); w.w = cvtpk(y1[2], y1[3]);
                        *(u32x4*)(dcol + (size_t)r * pitch + bj * HALF) = w; }
                    asm volatile("" ::: "memory"); }
        } else {
#pragma unroll
            for (int ai = 0; ai < 2; ++ai)
#pragma unroll
                for (int m = 0; m < 4; ++m) { const int r = row0 + ai * HALF + m * 16;
#pragma unroll
                    for (int bj = 0; bj < 2; ++bj) { f32x4 y0 = acc[ai][bj][m][0], y1 = acc[ai][bj][m][1];
                        if (kind == 3) {
#pragma unroll
                            for (int i = 0; i < 4; ++i) { y0[i] = silu1(y0[i]); y1[i] = silu1(y1[i]); } }
                        u32x4 w; w.x = cvtpk(y0[0], y0[1]); w.y = cvtpk(y0[2], y0[3]); w.z = cvtpk(y1[0], y1[1]); w.w = cvtpk(y1[2], y1[3]);
                        *(u32x4*)(dcol + (size_t)r * pitch + bj * HALF) = w; } }
        }
    }
};

struct EpiRes1 {
    static constexpr bool PERM = false, AFTER_DRAIN = true;
    const float* x; float* out; bf16_t* hb; float* ss1;
    __device__ __forceinline__ void fused(f32x4 (&acc)[2][2][4][2], const Unit& u, int wr, int wc, int fr, int fq, PG8_LAS unsigned char* lds, int wid, int lane) const {
        PG8_LAS float* Pp = (PG8_LAS float*)lds;
        const int col0 = u.pn * BM + wc * 32 + 4 * fq;
#pragma unroll
        for (int ai = 0; ai < 2; ++ai)
#pragma unroll
            for (int m = 0; m < 4; ++m) { const int rl = ai * HALF + wr * 64 + m * 16 + fr; const size_t off = (size_t)(u.pm * BM + rl) * 1024 + col0; float ss = 0.f;
#pragma unroll
                for (int bj = 0; bj < 2; ++bj)
#pragma unroll
                    for (int n = 0; n < 2; ++n) { const f32x4 h = *(const f32x4*)(x + off + bj * HALF + n * 16) + acc[ai][bj][m][n];
                        *(f32x4*)(out + off + bj * HALF + n * 16) = h; ss += (h[0] * h[0] + h[1] * h[1]) + (h[2] * h[2] + h[3] * h[3]);
                        unsigned w0 = cvtpk(h[0], h[1]), w1 = cvtpk(h[2], h[3]); *(unsigned long long*)(hb + off + bj * HALF + n * 16) = (unsigned long long)w0 | ((unsigned long long)w1 << 32); }
                ss += __shfl_xor(ss, 16); ss += __shfl_xor(ss, 32);
                if (fq == 0) Pp[rl * 4 + wc] = ss;
                if (m & 1) asm volatile("" ::: "memory"); }
        asm volatile("s_waitcnt lgkmcnt(0)" ::: "memory"); __builtin_amdgcn_s_barrier(); asm volatile("" ::: "memory");
        const int t = wid * 64 + lane;
        if (t < 256) { const f32x4 pp = *(const PG8_LAS f32x4*)(Pp + t * 4); ss1[(size_t)(u.pm * BM + t) * 4 + u.pn] = (pp[0] + pp[1]) + (pp[2] + pp[3]); }
    }
};
struct EpiRes2 {
    static constexpr bool PERM = false, AFTER_DRAIN = true;
    float* out;
    __device__ __forceinline__ void fused(f32x4 (&acc)[2][2][4][2], const Unit& u, int wr, int wc, int fr, int fq, PG8_LAS unsigned char* lds, int wid, int lane) const {
        const int col0 = u.pn * BM + wc * 32 + 4 * fq;
#pragma unroll
        for (int ai = 0; ai < 2; ++ai)
#pragma unroll
            for (int m = 0; m < 4; ++m) { const size_t off = (size_t)(u.pm * BM + ai * HALF + wr * 64 + m * 16 + fr) * 1024 + col0;
#pragma unroll
                for (int bj = 0; bj < 2; ++bj)
#pragma unroll
                    for (int n = 0; n < 2; ++n) { float* o = out + off + bj * HALF + n * 16; *(f32x4*)o = *(const f32x4*)o + acc[ai][bj][m][n]; }
                if (m & 1) asm volatile("" ::: "memory"); }
    }
};

template <class Epi, class Sched, bool ALIGN_EPI = false, bool SP2 = false>
__device__ __forceinline__ void gemm_phase(PG8_LAS unsigned char* lds, const Gemm g, const Sched& S, const Epi& E) {
    int tid_ = threadIdx.x; asm volatile("" : "+v"(tid_));
    const int tid = tid_, wid = __builtin_amdgcn_readfirstlane(tid >> 6), lane = tid & 63, wr = wid >> 2, wc = wid & 3, fr = lane & 15, fq = lane >> 4;
    const int K = g.K, nt = K / BK;
    unsigned voffA[2], voffB[2];
#pragma unroll
    for (int i = 0; i < 2; ++i) { int R, C; stage_rc(tid * 16 + i * 8192, R, C); const int Rb = Epi::PERM ? ((R & ~31) + perm32(R & 31)) : R;
        voffA[i] = (unsigned)(R * K + C) * 2u; voffB[i] = (unsigned)(Rb * K + C) * 2u; }
    const size_t kstep = (size_t)(BK * 2);
    const size_t hstep = (size_t)HALF * K * 2;
    const size_t tstep = 2 * hstep;
    const unsigned ldsw = (unsigned)wid * 1024u;
    const int aoff = lds_byte(wr * 64 + fr, fq * 8), boff = lds_byte(wc * 32 + fr, fq * 8);
#define PG8_SA(b, h) (((b) * 2 + (h)) * HTB)
#define PG8_SB(b, h) ((4 + (b) * 2 + (h)) * HTB)
#define PG8_STAGE(bufoff, gbase, voff) do { _Pragma("unroll") for (int _i = 0; _i < 2; ++_i) \
        __builtin_amdgcn_global_load_lds((const unsigned*)((const char*)(gbase) + (voff)[_i]), (PG8_LAS unsigned*)(lds + (bufoff) + ldsw + _i * 8192), 16, 0, 0); } while (0)
#define PG8_LDA(dst, b, h) do { _Pragma("unroll") for (int m = 0; m < 4; ++m) _Pragma("unroll") for (int k = 0; k < 2; ++k) dst[m][k] = *(const PG8_LAS bf16x8*)(lds + PG8_SA(b, h) + aoff + m * 2048 + k * 1024); } while (0)
#define PG8_LDB(dst, b, h) do { _Pragma("unroll") for (int n = 0; n < 2; ++n) _Pragma("unroll") for (int k = 0; k < 2; ++k) dst[n][k] = *(const PG8_LAS bf16x8*)(lds + PG8_SB(b, h) + boff + n * 2048 + k * 1024); } while (0)
#define PG8_MMA(ai, bj, At, Bt) do { __builtin_amdgcn_s_setprio(1); _Pragma("unroll") for (int m = 0; m < 4; ++m) _Pragma("unroll") for (int n = 0; n < 2; ++n) _Pragma("unroll") for (int k = 0; k < 2; ++k) \
        acc[ai][bj][m][n] = __builtin_amdgcn_mfma_f32_16x16x32_bf16(Bt[n][k], At[m][k], acc[ai][bj][m][n], 0, 0, 0); __builtin_amdgcn_s_setprio(0); } while (0)
#define PG8_WAIT_V(n) asm volatile("s_waitcnt vmcnt(" #n ")" ::: "memory")
#define PG8_WAIT_L(n) asm volatile("s_waitcnt lgkmcnt(" #n ")" ::: "memory")
#define PG8_BAR __builtin_amdgcn_s_barrier()
#define PG8_SCHED __builtin_amdgcn_sched_barrier(0)
    Unit cur, nxt; int ui = 0;
    if (!S.next(0, cur)) return;
    f32x4 acc[2][2][4][2];
#pragma unroll
    for (int a = 0; a < 2; ++a)
#pragma unroll
        for (int b = 0; b < 2; ++b)
#pragma unroll
            for (int m = 0; m < 4; ++m)
#pragma unroll
                for (int n = 0; n < 2; ++n) acc[a][b][m][n] = (f32x4){0.f, 0.f, 0.f, 0.f};
    bf16x8 At[4][2], B0[2][2], B1[2][2];
    const char* cA = (const char*)g.A + (size_t)cur.pm * tstep; const char* cB = (const char*)g.Bt + (size_t)cur.pn * tstep;
    S.a_ready(cur);
    if constexpr (SP2) {
        PG8_STAGE(PG8_SB(0, 0), cB, voffB); PG8_STAGE(PG8_SB(0, 1), cB + hstep, voffB); PG8_STAGE(PG8_SA(0, 0), cA, voffA); PG8_STAGE(PG8_SA(0, 1), cA + hstep, voffA);
        if (wr == 1) PG8_BAR;
        PG8_WAIT_V(2); PG8_BAR;
        PG8_STAGE(PG8_SB(1, 0), cB + kstep, voffB); PG8_STAGE(PG8_SA(1, 0), cA + kstep, voffA); PG8_STAGE(PG8_SB(1, 1), cB + hstep + kstep, voffB);
        PG8_WAIT_V(6); PG8_BAR;
    } else {
        PG8_STAGE(PG8_SB(0, 0), cB, voffB); PG8_STAGE(PG8_SA(0, 0), cA, voffA); PG8_STAGE(PG8_SB(0, 1), cB + hstep, voffB); PG8_STAGE(PG8_SA(0, 1), cA + hstep, voffA);
        if (wr == 1) PG8_BAR;
        PG8_WAIT_V(4); PG8_BAR;
        PG8_STAGE(PG8_SB(1, 0), cB + kstep, voffB); PG8_STAGE(PG8_SA(1, 0), cA + kstep, voffA); PG8_STAGE(PG8_SB(1, 1), cB + hstep + kstep, voffB);
        PG8_WAIT_V(6); PG8_BAR;
    }
    for (;;) {
        const bool has_next = S.next(ui + 1, nxt);
        const char* nA = has_next ? (const char*)g.A + (size_t)nxt.pm * tstep : cA; const char* nB = has_next ? (const char*)g.Bt + (size_t)nxt.pn * tstep : cB;
        for (int t = 0; t < nt; t += 2) {
            const bool last = (t == nt - 2);
            const char* a1 = cA + (size_t)(t + 1) * kstep;
            const char* a2 = last ? nA : cA + (size_t)(t + 2) * kstep; const char* b2 = last ? nB : cB + (size_t)(t + 2) * kstep;
            const char* a3 = a2 + kstep; const char* b3 = b2 + kstep;
            if (last && has_next) S.a_ready(nxt);
            if constexpr (SP2) {
            PG8_LDB(B0, 0, 0); PG8_LDB(B1, 0, 1); PG8_SCHED; PG8_LDA(At, 0, 0); PG8_STAGE(PG8_SA(1, 1), a1 + hstep, voffA);
            PG8_WAIT_V(8); PG8_WAIT_L(0); PG8_BAR; PG8_MMA(0, 0, At, B0); PG8_MMA(0, 1, At, B1); PG8_BAR; PG8_SCHED;
            PG8_LDA(At, 0, 1); PG8_STAGE(PG8_SB(0, 0), b2, voffB); PG8_STAGE(PG8_SB(0, 1), b2 + hstep, voffB); PG8_STAGE(PG8_SA(0, 0), a2, voffA);
            PG8_WAIT_V(8); PG8_WAIT_L(0); PG8_BAR; PG8_MMA(1, 0, At, B0); PG8_MMA(1, 1, At, B1); PG8_BAR; PG8_SCHED;
            PG8_LDB(B0, 1, 0); PG8_LDB(B1, 1, 1); PG8_SCHED; PG8_LDA(At, 1, 0); PG8_STAGE(PG8_SA(0, 1), a2 + hstep, voffA);
            PG8_WAIT_V(8); PG8_WAIT_L(0); PG8_BAR; PG8_MMA(0, 0, At, B0); PG8_MMA(0, 1, At, B1); PG8_BAR; PG8_SCHED;
            PG8_LDA(At, 1, 1); PG8_STAGE(PG8_SB(1, 0), b3, voffB); PG8_STAGE(PG8_SB(1, 1), b3 + hstep, voffB); PG8_STAGE(PG8_SA(1, 0), a3, voffA);
            PG8_WAIT_V(8); PG8_WAIT_L(0); PG8_BAR; PG8_MMA(1, 0, At, B0); PG8_MMA(1, 1, At, B1); PG8_BAR; PG8_SCHED;
            } else {
            PG8_LDB(B0, 0, 0); PG8_SCHED; PG8_LDA(At, 0, 0); PG8_STAGE(PG8_SA(1, 1), a1 + hstep, voffA);
            PG8_WAIT_L(8); PG8_BAR; PG8_WAIT_L(0); PG8_MMA(0, 0, At, B0); PG8_BAR; PG8_SCHED;
            PG8_LDB(B1, 0, 1); PG8_STAGE(PG8_SB(0, 0), b2, voffB);
            PG8_BAR; PG8_WAIT_L(0); PG8_MMA(0, 1, At, B1); PG8_BAR;
            PG8_LDA(At, 0, 1); PG8_STAGE(PG8_SA(0, 0), a2, voffA);
            PG8_BAR; PG8_WAIT_L(0); PG8_MMA(1, 0, At, B0); PG8_BAR; PG8_SCHED;
            PG8_STAGE(PG8_SB(0, 1), b2 + hstep, voffB);
            PG8_WAIT_V(6); PG8_BAR; PG8_MMA(1, 1, At, B1); PG8_BAR;
            PG8_LDB(B0, 1, 0); PG8_SCHED; PG8_LDA(At, 1, 0); PG8_STAGE(PG8_SA(0, 1), a2 + hstep, voffA);
            PG8_WAIT_L(8); PG8_BAR; PG8_WAIT_L(0); PG8_MMA(0, 0, At, B0); PG8_BAR; PG8_SCHED;
            PG8_LDB(B1, 1, 1); PG8_STAGE(PG8_SB(1, 0), b3, voffB);
            PG8_BAR; PG8_WAIT_L(0); PG8_MMA(0, 1, At, B1); PG8_BAR;
            PG8_LDA(At, 1, 1); PG8_STAGE(PG8_SA(1, 0), a3, voffA);
            PG8_BAR; PG8_WAIT_L(0); PG8_MMA(1, 0, At, B0); PG8_BAR; PG8_SCHED;
            PG8_STAGE(PG8_SB(1, 1), b3 + hstep, voffB);
            PG8_WAIT_V(6); PG8_BAR; PG8_MMA(1, 1, At, B1); PG8_BAR;
            }
        }
        if constexpr (ALIGN_EPI) { if (wr == 0) PG8_BAR; }
        if constexpr (!Epi::AFTER_DRAIN) { E(acc, cur, wr, wc, fr, fq); S.done(cur); }
        if (!has_next) break;
#pragma unroll
        for (int a = 0; a < 2; ++a)
#pragma unroll
            for (int b = 0; b < 2; ++b)
#pragma unroll
                for (int m = 0; m < 4; ++m)
#pragma unroll
                    for (int n = 0; n < 2; ++n) acc[a][b][m][n] = (f32x4){0.f, 0.f, 0.f, 0.f};
        cur = nxt; cA = nA; cB = nB; ++ui;
        if constexpr (ALIGN_EPI) { if (wr == 1) PG8_BAR; }
    }
    PG8_WAIT_V(0);
    if constexpr (!ALIGN_EPI) { if (wr == 0) PG8_BAR; }
    PG8_BAR;
    if constexpr (Epi::AFTER_DRAIN) { E.fused(acc, cur, wr, wc, fr, fq, lds, wid, lane); S.done(cur); }
#undef PG8_SA
#undef PG8_SB
#undef PG8_STAGE
#undef PG8_LDA
#undef PG8_LDB
#undef PG8_MMA
#undef PG8_WAIT_V
#undef PG8_WAIT_L
#undef PG8_BAR
#undef PG8_SCHED
}
}

namespace attn_body {
using bf16 = unsigned short;
using bf16x8 = __attribute__((ext_vector_type(8))) short;
using s16x4 = __attribute__((ext_vector_type(4))) short;
using f32x16 = __attribute__((ext_vector_type(16))) float;
using f32x4 = __attribute__((ext_vector_type(4))) float;
using u32x4 = __attribute__((ext_vector_type(4))) unsigned;
constexpr int SEQ = 2048, D = 64, DM = 1024;
constexpr int NW = 8, QBLK = 32, QB = QBLK * NW, KVBLK = 64;
__device__ __forceinline__ int crow(int r, int hi) { return (r & 3) + 8 * (r >> 2) + 4 * hi; }
#define SBAR() __builtin_amdgcn_sched_barrier(0)
template <int MODE> __device__ __forceinline__ void amask(f32x16& p0, f32x16& p1, int d) {
  const float NEG = -INFINITY; asm volatile("" : "+v"(d)); const int d2 = d - 128;
  #pragma unroll
  for (int r = 0; r < 16; ++r) { const int c = (r & 3) + 8 * (r >> 2);
    if (MODE == 0) { if (c > d) p0[r] = NEG; if (c + 32 > d) p1[r] = NEG; }
    else { if (c > d || c <= d2) p0[r] = NEG; if (c + 32 > d || c + 32 <= d2) p1[r] = NEG; } }
}
constexpr int NSLOT = 3, SLOTB = 8192;
constexpr int LDS_K = 0, LDS_V = NSLOT * SLOTB, LDS_WS = 2 * NSLOT * SLOTB, LDS_BU = LDS_WS + NW * 64 * 4, LDS_OST = LDS_BU + 8192, LDS_BYTES = LDS_OST + NW * 8192;
__device__ __forceinline__ void glds16(const void* sbase, unsigned voff, unsigned lds_dst) { unsigned keep;
  asm volatile("s_nop 4\n\ts_mov_b32 %0, m0\n\ts_mov_b32 m0, %3\n\ts_nop 0\n\tglobal_load_lds_dwordx4 %1, %2\n\ts_mov_b32 m0, %0" : "=&s"(keep) : "v"(voff), "s"(sbase), "s"(lds_dst) : "memory"); }
typedef float f32x2_t __attribute__((ext_vector_type(2))); typedef __bf16 bf16x2_t __attribute__((ext_vector_type(2)));
__device__ __forceinline__ unsigned cvtpk_s(float lo, float hi) { f32x2_t v = {lo, hi}; bf16x2_t b = __builtin_convertvector(v, bf16x2_t); return __builtin_bit_cast(unsigned, b); }
#define WAIT_BAR(N) asm volatile("s_waitcnt vmcnt(" #N ") lgkmcnt(0)\n\ts_barrier" ::: "memory")
typedef __attribute__((address_space(3))) const char* lds_cptr;
typedef short v4i16_t __attribute__((ext_vector_type(4)));
__device__ __forceinline__ void kload8(bf16x8* kf, lds_cptr kp) {
  kf[0] = *(const __attribute__((address_space(3))) bf16x8*)(kp);        kf[1] = *(const __attribute__((address_space(3))) bf16x8*)(kp + 512);
  kf[2] = *(const __attribute__((address_space(3))) bf16x8*)(kp + 2048); kf[3] = *(const __attribute__((address_space(3))) bf16x8*)(kp + 2560);
  kf[4] = *(const __attribute__((address_space(3))) bf16x8*)(kp + 4096); kf[5] = *(const __attribute__((address_space(3))) bf16x8*)(kp + 4608);
  kf[6] = *(const __attribute__((address_space(3))) bf16x8*)(kp + 6144); kf[7] = *(const __attribute__((address_space(3))) bf16x8*)(kp + 6656);
}
__device__ __forceinline__ void kload2(bf16x8* kf, lds_cptr kp, int j) { kf[2 * j] = *(const __attribute__((address_space(3))) bf16x8*)(kp + j * 2048); kf[2 * j + 1] = *(const __attribute__((address_space(3))) bf16x8*)(kp + j * 2048 + 512); }
__device__ __forceinline__ s16x4 vtr(lds_cptr p) { return __builtin_bit_cast(s16x4, __builtin_amdgcn_ds_read_tr16_b64_v4i16((__attribute__((address_space(3))) v4i16_t*)p)); }
__device__ __forceinline__ void pv(f32x16* o, int vb, bf16x8 pa0, bf16x8 pa1, bf16x8 pa2, bf16x8 pa3) {
  #pragma unroll
  for (int d0 = 0; d0 < 2; ++d0) { s16x4 lo[4], hi[4];
    #pragma unroll
    for (int ks = 0; ks < 4; ++ks) {
      asm volatile("ds_read_b64_tr_b16 %0,%1 offset:%c2" : "=&v"(lo[ks]) : "v"(vb), "i"(d0 * 4096 + ks * 1024) : "memory");
      asm volatile("ds_read_b64_tr_b16 %0,%1 offset:%c2" : "=&v"(hi[ks]) : "v"(vb), "i"(d0 * 4096 + ks * 1024 + 512) : "memory"); }
    asm volatile("s_waitcnt lgkmcnt(0)" ::: "memory"); SBAR();
    #define PK(k) (bf16x8){lo[k][0], lo[k][1], lo[k][2], lo[k][3], hi[k][0], hi[k][1], hi[k][2], hi[k][3]}
    o[d0] = __builtin_amdgcn_mfma_f32_32x32x16_bf16(pa0, PK(0), o[d0], 0, 0, 0);
    o[d0] = __builtin_amdgcn_mfma_f32_32x32x16_bf16(pa1, PK(1), o[d0], 0, 0, 0);
    o[d0] = __builtin_amdgcn_mfma_f32_32x32x16_bf16(pa2, PK(2), o[d0], 0, 0, 0);
    o[d0] = __builtin_amdgcn_mfma_f32_32x32x16_bf16(pa3, PK(3), o[d0], 0, 0, 0);
    #undef PK
  }
}

struct AUnit { int b, kvh, hq, q0, T0; };
template <int MODE> __device__ __forceinline__ void attn_unit(const AUnit u, const AUnit un, bool has_prev, bool has_next, bf16x8 (&qr)[4], const bf16* Q, const bf16* __restrict__ K, const bf16* __restrict__ V, const bf16* __restrict__ G, bf16* O, const float* ckb, const float* sinks, char* shm) {
  constexpr int KP = MODE ? 256 : 1024;
  constexpr int QROWS = MODE ? 128 : 256;
  int tid_ = threadIdx.x; asm volatile("" : "+v"(tid_));
  const int tid = tid_, lane = tid & 63, r32 = lane & 31, hi = lane >> 5; const int wid = __builtin_amdgcn_readfirstlane(tid >> 6);
  const int hw = MODE ? u.hq + (wid >> 2) : u.hq, rw = MODE ? 32 * (wid & 3) : 32 * wid;
  const long rowbase = (long)u.b * SEQ; const int q0 = u.q0, T0 = u.T0;
  const int NT = (q0 + QROWS) / KVBLK - T0;
  const bf16* Kh = K + (rowbase + (long)T0 * KVBLK) * KP + u.kvh * D, *Vh = V + (rowbase + (long)T0 * KVBLK) * KP + u.kvh * D;
  const unsigned lds0 = (unsigned)(uintptr_t)shm;
  const lds_cptr shm3 = (lds_cptr)shm;
  const unsigned koff = (unsigned)(lane * KP + wid * 8) * 2u;
  const unsigned voff = (unsigned)((16 * (wid & 3) + (lane >> 2)) * KP + (wid >> 2) * 32 + (lane & 3) * 8) * 2u;
  const unsigned kdst = lds0 + LDS_K + wid * 1024, vdst = lds0 + LDS_V + wid * 1024;
  #define DMA_K(t, slot) glds16(Kh + (long)(t) * KVBLK * KP, koff, (unsigned)__builtin_amdgcn_readfirstlane(kdst + (slot)))
  #define DMA_V(t, slot) glds16(Vh + (long)(t) * KVBLK * KP, voff, (unsigned)__builtin_amdgcn_readfirstlane(vdst + (slot)))
  const int vb0 = (int)(lds0 + LDS_V) + ((lane >> 4) & 1) * 32 + (lane & 3) * 8 + (4 * hi + ((lane & 15) >> 2)) * 64;
  bf16x8 kf[8];
  const lds_cptr kp0 = shm3 + LDS_K + hi * 1024 + r32 * 16; const lds_cptr vp0 = shm3 + LDS_V + ((lane >> 4) & 1) * 32 + (lane & 3) * 8 + (4 * hi + ((lane & 15) >> 2)) * 64;
  const __attribute__((address_space(3))) f32x4* bup = (const __attribute__((address_space(3))) f32x4*)(shm3 + LDS_BU) + hi;
  if (!has_prev) {
    DMA_K(0, 0); DMA_V(0, 0); DMA_K(1, SLOTB);
    const bf16* Qw = Q + (rowbase + q0 + rw) * DM + hw * D;
    #pragma unroll
    for (int d0 = 0; d0 < 4; ++d0) qr[d0] = *reinterpret_cast<const bf16x8*>(&Qw[(long)r32 * DM + d0 * 16 + hi * 8]);
    if (MODE == 0) {
      const float* ck = ckb + (size_t)(u.b * 16 + u.hq) * SEQ;
      const int nk = q0 + QROWS; const float cref = __hip_atomic_load((float*)ck + (nk - 1), __ATOMIC_RELAXED, __HIP_MEMORY_SCOPE_AGENT);
      const int k0 = tid * 4;
      if (k0 < nk) { const f32x4 c = *(const f32x4*)(ck + k0); *(f32x4*)((float*)(shm + LDS_BU) + k0) = (f32x4){cref, cref, cref, cref} - c; }
    }
    DMA_K(2, 2 * SLOTB);
  }
  float l_reg = 0.f; f32x16 o[2]; o[0] = f32x16{}; o[1] = f32x16{};
  const int dq = rw + r32 - (T0 * KVBLK - q0) - 4 * hi;
  #define CMASK(P0, P1, t) do { if (MODE == 1 || (t) >= NT - 4) amask<MODE>(P0, P1, dq - 64 * (t)); } while (0)
  #define MFMA32(a, b, c) __builtin_amdgcn_mfma_f32_32x32x16_bf16(a, b, c, 0, 0, 0)
  #define CI(X) (MODE ? f32x16{} : (X))
  #define BLD(P, base, j0) do { if (MODE == 0) { const f32x4 u_ = bup[(base) + 2 * (j0)], v_ = bup[(base) + 2 * (j0) + 2]; \
      P[4 * (j0)] = u_[0]; P[4 * (j0) + 1] = u_[1]; P[4 * (j0) + 2] = u_[2]; P[4 * (j0) + 3] = u_[3]; P[4 * (j0) + 4] = v_[0]; P[4 * (j0) + 5] = v_[1]; P[4 * (j0) + 6] = v_[2]; P[4 * (j0) + 7] = v_[3]; } } while (0)
  f32x16 pA0, pA1, pB0, pB1;
  int sl_prev = 0, sl_cur = 0, sl_next = SLOTB;
  #define ROT() do { sl_prev = sl_cur; sl_cur = sl_next; sl_next = (sl_next == (NSLOT - 1) * SLOTB) ? 0 : sl_next + SLOTB; } while (0)
  WAIT_BAR(3);
  if (MODE == 0) { BLD(pA0, 0, 0); BLD(pA0, 0, 2); BLD(pA1, 8, 0); BLD(pA1, 8, 2); }
  { const char* kb = shm + LDS_K + hi * 1024 + r32 * 16;
    #pragma unroll
    for (int d0 = 0; d0 < 4; ++d0) {
      const bf16x8 b0 = *reinterpret_cast<const bf16x8*>(kb + d0 * 2048);
      const bf16x8 b1 = *reinterpret_cast<const bf16x8*>(kb + d0 * 2048 + 512);
      if (d0 == 0) { pA0 = MFMA32(b0, qr[0], CI(pA0)); pA1 = MFMA32(b1, qr[0], CI(pA1)); }
      else { pA0 = MFMA32(b0, qr[d0], pA0); pA1 = MFMA32(b1, qr[d0], pA1); } } }
  CMASK(pA0, pA1, 0);
  _Pragma("unroll") for (int r = 0; r < 16; ++r) { pA0[r] = __builtin_amdgcn_exp2f(pA0[r]); pA1[r] = __builtin_amdgcn_exp2f(pA1[r]); }
  WAIT_BAR(0);
  DMA_K(3, 0); DMA_V(1, SLOTB);
  ROT();
  kload8(kf, kp0 + sl_cur);
  if (MODE == 0) { BLD(pB0, 16, 0); BLD(pB0, 16, 2); BLD(pB1, 24, 0); BLD(pB1, 24, 2); }
  WAIT_BAR(2);
  s16x4 vlo[8], vhi[8]; u32x4 pw0, pw1, pw2, pw3;
  #define PKW(P, B) cvtpk_s(P[B], P[B + 1])
  #define PAF(k) __builtin_bit_cast(bf16x8, pw##k)
  #define VFR(i) (bf16x8){vlo[i][0], vlo[i][1], vlo[i][2], vlo[i][3], vhi[i][0], vhi[i][1], vhi[i][2], vhi[i][3]}
  #define PIN(x) asm volatile("" : "+v"(x))
  #define GAPA(MF, A0, A1, A2, A3, W0, W1, PW) do { MF; sacc += A0; sacc += A1; sacc += A2; sacc += A3; PIN(sacc); W0; W1; PIN(PW); SBAR(); } while (0)
  #define EX(v) __builtin_amdgcn_exp2f(v)
  #define GAPB(MF, X, B) do { MF; X[B] = EX(X[B]); X[B + 1] = EX(X[B + 1]); X[B + 2] = EX(X[B + 2]); X[B + 3] = EX(X[B + 3]); PIN(X); SBAR(); } while (0)
  #define VRD(i) do { vlo[i] = vtr(vp_ + (((i) >> 2) * 4096 + ((i) & 3) * 1024)); vhi[i] = vtr(vp_ + (((i) >> 2) * 4096 + ((i) & 3) * 1024 + 512)); } while (0)
  #define KRD(G_, j) do { if (G_) { kload2(kf, kp0 + sl_next, j); SBAR(); } } while (0)
  #define BRD(G_, P, base, j0) do { if ((G_) && MODE == 0) { BLD(P, base, j0); SBAR(); } } while (0)
  #define STEP(C0, C1, P0, P1, t, GK, GV, GL) do { SBAR(); \
    const lds_cptr vp_ = vp0 + sl_prev; const int bb_ = 16 * ((t) + 1); \
    VRD(0); SBAR(); float sacc = (P0[0] + P0[1]); \
    GAPA(C0 = MFMA32(kf[0], qr[0], CI(C0)), P0[2], P0[3], P0[4], P0[5],     pw0[0] = PKW(P0, 0), pw0[1] = PKW(P0, 2), pw0); \
    VRD(4); SBAR(); GAPA(C1 = MFMA32(kf[1], qr[0], CI(C1)), P0[6], P0[7], P0[8], P0[9],     pw0[2] = PKW(P0, 4), pw0[3] = PKW(P0, 6), pw0); \
    VRD(1); SBAR(); GAPA(C0 = MFMA32(kf[2], qr[1], C0),   P0[10], P0[11], P0[12], P0[13], pw1[0] = PKW(P0, 8), pw1[1] = PKW(P0, 10), pw1); \
    VRD(5); SBAR(); GAPA(C1 = MFMA32(kf[3], qr[1], C1),   P0[14], P0[15], P1[0], P1[1],   pw1[2] = PKW(P0, 12), pw1[3] = PKW(P0, 14), pw1); \
    VRD(2); SBAR(); GAPA(C0 = MFMA32(kf[4], qr[2], C0),   P1[2], P1[3], P1[4], P1[5],     pw2[0] = PKW(P1, 0), pw2[1] = PKW(P1, 2), pw2); \
    VRD(6); SBAR(); GAPA(C1 = MFMA32(kf[5], qr[2], C1),   P1[6], P1[7], P1[8], P1[9],     pw2[2] = PKW(P1, 4), pw2[3] = PKW(P1, 6), pw2); \
    VRD(3); SBAR(); GAPA(C0 = MFMA32(kf[6], qr[3], C0),   P1[10], P1[11], P1[12], P1[13], pw3[0] = PKW(P1, 8), pw3[1] = PKW(P1, 10), pw3); \
    VRD(7); SBAR(); GAPA(C1 = MFMA32(kf[7], qr[3], C1),   P1[14], P1[15], 0.f, 0.f,       pw3[2] = PKW(P1, 12), pw3[3] = PKW(P1, 14), pw3); \
    l_reg += sacc; \
    if (GK) { DMA_K((t) + 3, sl_cur); } if (GV) { DMA_V((t) + 1, sl_next); } \
    CMASK(C0, C1, t); \
    SBAR(); \
    BRD(GL, P0, bb_, 0); GAPB(o[0] = MFMA32(PAF(0), VFR(0), o[0]), C0, 0); \
    BRD(GL, P0, bb_, 2); GAPB(o[1] = MFMA32(PAF(0), VFR(4), o[1]), C0, 4); \
    KRD(GL, 0); GAPB(o[0] = MFMA32(PAF(1), VFR(1), o[0]), C0, 8); \
    KRD(GL, 1); GAPB(o[1] = MFMA32(PAF(1), VFR(5), o[1]), C0, 12); \
    KRD(GL, 2); GAPB(o[0] = MFMA32(PAF(2), VFR(2), o[0]), C1, 0); \
    KRD(GL, 3); GAPB(o[1] = MFMA32(PAF(2), VFR(6), o[1]), C1, 4); \
    BRD(GL, P1, bb_ + 8, 0); GAPB(o[0] = MFMA32(PAF(3), VFR(3), o[0]), C1, 8); \
    BRD(GL, P1, bb_ + 8, 2); GAPB(o[1] = MFMA32(PAF(3), VFR(7), o[1]), C1, 12); \
    } while (0)
  int t = 1;
  #undef CMASK
  #define CMASK(P0, P1, t) do {} while (0)
  for (; t + 5 < NT; t += 2) {
    STEP(pB0, pB1, pA0, pA1, t, true, true, true);     WAIT_BAR(2); ROT();
    STEP(pA0, pA1, pB0, pB1, t + 1, true, true, true); WAIT_BAR(2); ROT();
  }
  #undef CMASK
  #define CMASK(P0, P1, t) do { if (MODE == 1 || (t) >= NT - 4) amask<MODE>(P0, P1, dq - 64 * (t)); } while (0)
  #define ENDW(tt) do { if ((tt) + 3 < NT) { WAIT_BAR(2); } else if ((tt) + 2 < NT) { WAIT_BAR(1); } else { WAIT_BAR(0); } } while (0)
  for (; t + 1 < NT; t += 2) {
    STEP(pB0, pB1, pA0, pA1, t, (t + 3 < NT), (t + 1 < NT), (t + 1 < NT));         ENDW(t);     ROT();
    STEP(pA0, pA1, pB0, pB1, t + 1, (t + 4 < NT), (t + 2 < NT), (t + 2 < NT));     ENDW(t + 1); ROT();
  }
  STEP(pB0, pB1, pA0, pA1, NT - 1, false, false, false);
  u32x4 gv[4];
  { const bf16* Gw0 = G + (rowbase + q0 + rw) * DM + hw * D;
    #pragma unroll
    for (int i = 0; i < 4; ++i) gv[i] = *(const u32x4*)(Gw0 + (long)(i * 8 + (lane >> 3)) * DM + (lane & 7) * 8); }
  f32x4 cn = {}; float crefn = 0.f; const int k0n = tid * 4, nkn = un.q0 + QROWS;
  if (has_next) {
    const int hwn = MODE ? un.hq + (wid >> 2) : un.hq;
    const bf16* Qn = Q + ((long)un.b * SEQ + un.q0 + rw) * DM + hwn * D;
    #pragma unroll
    for (int d0 = 0; d0 < 4; ++d0) qr[d0] = *reinterpret_cast<const bf16x8*>(&Qn[(long)r32 * DM + d0 * 16 + hi * 8]);
    if (MODE == 0) { const float* ckn = ckb + (size_t)(un.b * 16 + un.hq) * SEQ; crefn = __hip_atomic_load((float*)ckn + (nkn - 1), __ATOMIC_RELAXED, __HIP_MEMORY_SCOPE_AGENT); if (k0n < nkn) cn = *(const f32x4*)(ckn + k0n); }
  }
  { float sacc = pB0[0] + pB0[1]; _Pragma("unroll") for (int r = 2; r < 16; ++r) sacc += pB0[r]; _Pragma("unroll") for (int r = 0; r < 16; ++r) sacc += pB1[r]; l_reg += sacc;
    pw0 = (u32x4){PKW(pB0, 0), PKW(pB0, 2), PKW(pB0, 4), PKW(pB0, 6)}; pw1 = (u32x4){PKW(pB0, 8), PKW(pB0, 10), PKW(pB0, 12), PKW(pB0, 14)}; pw2 = (u32x4){PKW(pB1, 0), PKW(pB1, 2), PKW(pB1, 4), PKW(pB1, 6)}; pw3 = (u32x4){PKW(pB1, 8), PKW(pB1, 10), PKW(pB1, 12), PKW(pB1, 14)};
    SBAR(); pv(o, vb0 + sl_cur, PAF(0), PAF(1), PAF(2), PAF(3)); }
  asm volatile("s_waitcnt lgkmcnt(0)\n\ts_barrier" ::: "memory");
  if (has_next) {
    if (MODE == 0) { if (k0n < nkn) *(f32x4*)((float*)(shm + LDS_BU) + k0n) = (f32x4){crefn, crefn, crefn, crefn} - cn; }
    const bf16* Khn = K + ((long)un.b * SEQ + (long)un.T0 * KVBLK) * KP + un.kvh * D, *Vhn = V + ((long)un.b * SEQ + (long)un.T0 * KVBLK) * KP + un.kvh * D;
    glds16(Khn, koff, (unsigned)__builtin_amdgcn_readfirstlane(kdst)); glds16(Vhn, voff, (unsigned)__builtin_amdgcn_readfirstlane(vdst));
    glds16(Khn + (long)KVBLK * KP, koff, (unsigned)__builtin_amdgcn_readfirstlane(kdst + SLOTB)); glds16(Khn + 2L * KVBLK * KP, koff, (unsigned)__builtin_amdgcn_readfirstlane(kdst + 2 * SLOTB));
  }
  #undef PKW
  #undef PAF
  #undef VFR
  #undef PIN
  #undef GAPA
  #undef GAPB
  #undef EX
  #undef VRD
  #undef KRD
  #undef BRD
  #undef STEP
  #undef ENDW
  { auto rr = __builtin_amdgcn_permlane32_swap(__float_as_uint(l_reg), __float_as_uint(l_reg), false, false); l_reg = __uint_as_float(rr[0]) + __uint_as_float(rr[1]); }
  if (MODE == 1) l_reg += __builtin_amdgcn_exp2f(sinks[hw] * 1.4426950408889634f);
  int lane_e = lane; asm volatile("" : "+v"(lane_e));
  const int r32e = lane_e & 31, hie = lane_e >> 5;
  float* wsfe = (float*)(shm + LDS_WS) + wid * 64;
  if (hie == 0) wsfe[32 + r32e] = l_reg; asm volatile("s_waitcnt lgkmcnt(0)" ::: "memory");
  float rli[16];
  #pragma unroll
  for (int r = 0; r < 16; ++r) rli[r] = __builtin_amdgcn_rcpf(wsfe[32 + crow(r, hie)]);
  bf16* Ow = O + (rowbase + q0 + rw) * DM + hw * D;
  { float* stg = (float*)(shm + LDS_OST) + wid * 2048;
    #pragma unroll
    for (int r = 0; r < 16; ++r) { const int orow = crow(r, hie);
      #pragma unroll
      for (int d0 = 0; d0 < 2; ++d0) stg[orow * 64 + d0 * 32 + r32e] = o[d0][r] * rli[r]; }
    asm volatile("s_waitcnt lgkmcnt(0)" ::: "memory");
    #pragma unroll
    for (int i = 0; i < 4; ++i) { const int row = i * 8 + (lane_e >> 3), ch = lane_e & 7;
      const f32x4 a0 = *(const f32x4*)(stg + row * 64 + ch * 8), a1 = *(const f32x4*)(stg + row * 64 + ch * 8 + 4);
      u32x4 w;
      w.x = cvtpk_s(a0[0] * __uint_as_float(gv[i].x << 16), a0[1] * __uint_as_float(gv[i].x & 0xffff0000u));
      w.y = cvtpk_s(a0[2] * __uint_as_float(gv[i].y << 16), a0[3] * __uint_as_float(gv[i].y & 0xffff0000u));
      w.z = cvtpk_s(a1[0] * __uint_as_float(gv[i].z << 16), a1[1] * __uint_as_float(gv[i].z & 0xffff0000u));
      w.w = cvtpk_s(a1[2] * __uint_as_float(gv[i].w << 16), a1[3] * __uint_as_float(gv[i].w & 0xffff0000u));
      *(u32x4*)(Ow + (long)row * DM + ch * 8) = w; } }
  #undef DMA_K
  #undef DMA_V
  #undef CMASK
  #undef MFMA32
  #undef CI
  #undef BLD
  #undef ROT
}
constexpr int ATTN_LDS_BYTES = LDS_BYTES;
#undef SBAR
#undef WAIT_BAR
}

constexpr int NWAVES = 8;
constexpr size_t WS_DUMMY = 184 * MiB;
constexpr int N_PHASES = 7;
constexpr size_t CTL_ZERO_BYTES = 1 * MiB;
constexpr int CW_BAR = 4096;
constexpr int RING_OFF = 0, RING_BYTES = 131072;
constexpr int LDSCTL_OFF = RING_BYTES, MISC_OFF = LDSCTL_OFF + 320;
constexpr int XCH_OFF = RING_BYTES + 1024;
constexpr int LDS_BYTES = 147456;
static_assert(XCH_OFF + 8192 <= LDS_BYTES && MISC_OFF + 128 <= XCH_OFF, "LDS map");

#define GAS __attribute__((address_space(1)))
#define LAS __attribute__((address_space(3)))
typedef unsigned v4u __attribute__((ext_vector_type(4)));
typedef GAS unsigned gu32;
#define RLX_AGENT __ATOMIC_RELAXED, __HIP_MEMORY_SCOPE_AGENT
#define LDS_WAIT() asm volatile("s_waitcnt lgkmcnt(0)" ::: "memory")
#define VM_WAIT() asm volatile("s_waitcnt vmcnt(0)" ::: "memory")
__device__ __forceinline__ unsigned pk2(float lo, float hi) { return f2bf(lo) | (f2bf(hi) << 16); }

#define XB_TMO      128
#define XB_XCNT(j)  (256  + 64 * (j))
#define XB_XSUB(j)  (1280 + 64 * (j))
#define XB_XGEN(j)  (2304 + 64 * (j))
#define XB_TOP      3328
#define XB_TOPGEN   3392
#define XCD_BAR_WORDS 3456
#define XB_SPIN_CAP (1u << 18)

__device__ __forceinline__ unsigned xb_ld(unsigned* p)              { return __hip_atomic_load(p, __ATOMIC_RELAXED, __HIP_MEMORY_SCOPE_AGENT); }
__device__ __forceinline__ unsigned xb_add(unsigned* p, unsigned v) { return __hip_atomic_fetch_add(p, v, __ATOMIC_RELAXED, __HIP_MEMORY_SCOPE_AGENT); }
__device__ __forceinline__ unsigned xb_xcc_id() { return (unsigned)__builtin_amdgcn_s_getreg((3 << 11) | 20) & 0xFu; }
#define XB_SPIN(cond, bar) do { unsigned _sp = 0; while (cond) { __builtin_amdgcn_s_sleep(1); \
    if ((++_sp & 255u) == 0u) { if (xb_ld(&(bar)[XB_TMO])) break; if (_sp > XB_SPIN_CAP) { atomicAdd(&(bar)[XB_TMO], 1u); break; } } } } while (0)

struct XcdBarrier {
    unsigned* bar; unsigned x;
    volatile LAS unsigned* st;
};

__device__ __forceinline__ XcdBarrier xcd_barrier_post(unsigned* bar, volatile LAS unsigned* st) {
    XcdBarrier b; b.bar = bar; b.x = xb_xcc_id(); b.st = st;
    if (threadIdx.x == 0) (void)xb_add(&bar[XB_XCNT(b.x)], 1u);
    return b;
}
__device__ __forceinline__ void xcd_barrier_complete(unsigned* bar, unsigned x, unsigned& nloc, unsigned& nx) {
    const unsigned G = gridDim.x * gridDim.y * gridDim.z;
    unsigned sum, cnt, mine, sp = 0u;
    for (;;) {
        sum = 0u; cnt = 0u; mine = 0u;
#pragma unroll
        for (unsigned j = 0; j < 16; ++j) { const unsigned c = xb_ld(&bar[XB_XCNT(j)]); sum += c; cnt += (c > 0u) ? 1u : 0u; mine = (j == x) ? c : mine; }
        if (sum == G) break;
        __builtin_amdgcn_s_sleep(1);
        if ((++sp & 255u) == 0u) { if (xb_ld(&bar[XB_TMO])) break; if (sp > XB_SPIN_CAP) { atomicAdd(&bar[XB_TMO], 1u); break; } }
    }
    nloc = mine > 0u ? mine : 1u; nx = cnt > 0u ? cnt : 1u;
}

__device__ __forceinline__ void xcd_barrier(const XcdBarrier& b) {
    asm volatile("s_waitcnt vmcnt(0)" ::: "memory");
    __syncthreads();
    if (threadIdx.x == 0) {
        unsigned* bar = b.bar;
        __builtin_amdgcn_s_waitcnt(0);
        unsigned nloc = b.st[0], nx = b.st[1];
        if (nloc == 0u) { xcd_barrier_complete(bar, b.x, nloc, nx); b.st[0] = nloc; b.st[1] = nx; }
        const unsigned old = xb_add(&bar[XB_XSUB(b.x)], 1u);
        const unsigned gen = old / nloc;
        if (old + 1u == (gen + 1u) * nloc) {
            __builtin_amdgcn_fence(__ATOMIC_RELEASE, "agent");
            asm volatile("s_waitcnt vmcnt(0)" ::: "memory");
            const unsigned og = xb_add(&bar[XB_TOP], 1u);
            const unsigned tg = og / nx;
            if (og + 1u == (tg + 1u) * nx) xb_add(&bar[XB_TOPGEN], 1u);
            else XB_SPIN(xb_ld(&bar[XB_TOPGEN]) == tg, bar);
            __builtin_amdgcn_fence(__ATOMIC_ACQUIRE, "agent");
            xb_add(&bar[XB_XGEN(b.x)], 1u);
            asm volatile("s_waitcnt vmcnt(0)" ::: "memory");
        } else {
            XB_SPIN(xb_ld(&bar[XB_XGEN(b.x)]) == gen, bar);
            __builtin_amdgcn_fence(__ATOMIC_ACQUIRE, "agent");
            asm volatile("s_waitcnt vmcnt(0)" ::: "memory");
        }
    }
    __syncthreads();
}

struct Frame {
    LAS unsigned char* lds;
    volatile LAS unsigned* MISC;
    gu32* ctl;
    int tid, lane, wave;
    int vcu, G;
};

__device__ __forceinline__ void p0_transpose_item(const float* W, int ldw, int col0, const float* gain, bf16_t* WT, LAS float* scr, int k0, int lane) {
    float w[32];
#pragma unroll
    for (int i = 0; i < 32; ++i) w[i] = W[(size_t)(k0 + 2 * i + (lane >> 5)) * ldw + col0 + (lane & 31)];
    const int c = lane & 7;
    f32x4 g0 = {1.f, 1.f, 1.f, 1.f}, g1 = g0;
    if (gain) { g0 = *(const f32x4*)(gain + k0 + 8 * c); g1 = *(const f32x4*)(gain + k0 + 8 * c + 4); }
#pragma unroll
    for (int i = 0; i < 32; ++i) { const int kk = 2 * i + (lane >> 5); scr[kk * 32 + ((lane & 31) ^ (((kk >> 3) & 7) << 2))] = w[i]; }
    LDS_WAIT(); asm volatile("" ::: "memory");
#pragma unroll
    for (int j = 0; j < 4; ++j) { const int n = (lane >> 3) + 8 * j; const LAS float* s = scr + (8 * c) * 32 + (n ^ (c << 2));
        v4u o; o.x = pk2(s[0 * 32] * g0[0], s[1 * 32] * g0[1]); o.y = pk2(s[2 * 32] * g0[2], s[3 * 32] * g0[3]); o.z = pk2(s[4 * 32] * g1[0], s[5 * 32] * g1[1]); o.w = pk2(s[6 * 32] * g1[2], s[7 * 32] * g1[3]);
        *(GAS v4u*)(WT + (size_t)n * 1024 + k0 + 8 * c) = o; }
    LDS_WAIT(); asm volatile("" ::: "memory");
}
__device__ __forceinline__ void p0_rows4(Frame& F, const P& p, int m0, const LAS float* WFl) {
    bf16_t* XB = (bf16_t*)(p.ws + WS_XB); float* RS0 = (float*)(p.ws + WS_RS0); float* LF = (float*)(p.ws + WS_LF);
    const int lane = F.lane;
    f32x4 v[4][4]; float rstd[4];
#pragma unroll
    for (int r = 0; r < 4; ++r) { const f32x4* xr = (const f32x4*)(p.x + (size_t)(m0 + r) * 1024) + lane; float ss = 0.f;
#pragma unroll
        for (int j = 0; j < 4; ++j) { v[r][j] = xr[64 * j]; ss += (v[r][j][0] * v[r][j][0] + v[r][j][1] * v[r][j][1]) + (v[r][j][2] * v[r][j][2] + v[r][j][3] * v[r][j][3]); }
        ss = wave_sum(ss); rstd[r] = 1.0f / sqrtf(ss * (1.0f / 1024.0f) + EPS); }
#pragma unroll
    for (int r = 0; r < 4; ++r)
#pragma unroll
        for (int j = 0; j < 4; ++j) { uint2 o; o.x = pk2(v[r][j][0], v[r][j][1]); o.y = pk2(v[r][j][2], v[r][j][3]); *(uint2*)(XB + (size_t)(m0 + r) * 1024 + 4 * (lane + 64 * j)) = o; }
    float a[64];
#pragma unroll
    for (int i = 0; i < 64; ++i) a[i] = 0.f;
#pragma unroll
    for (int h = 0; h < 16; ++h)
#pragma unroll
        for (int j = 0; j < 4; ++j) { const f32x4 w = *(const LAS f32x4*)(WFl + h * 1024 + 4 * (lane + 64 * j));
#pragma unroll
            for (int r = 0; r < 4; ++r) a[r * 16 + h] += (v[r][j][0] * w[0] + v[r][j][1] * w[1]) + (v[r][j][2] * w[2] + v[r][j][3] * w[3]);
            if (j == 3) asm volatile("" ::: "memory"); }
#define TR_STEP(OFF) { const bool up = (lane & OFF) != 0; _Pragma("unroll") for (int i = 0; i < OFF; ++i) { const float keep = up ? a[i + OFF] : a[i]; const float send = up ? a[i] : a[i + OFF]; a[i] = keep + __shfl_xor(send, OFF); } }
    TR_STEP(32) TR_STEP(16) TR_STEP(8) TR_STEP(4) TR_STEP(2) TR_STEP(1)
#undef TR_STEP
    const int rsel = lane >> 4, h = lane & 15;
    const float rsd = rsel == 0 ? rstd[0] : rsel == 1 ? rstd[1] : rsel == 2 ? rstd[2] : rstd[3];
    const float z = a[0] * rsd + p.b_forget[h];
    const float lf = fminf(z, 0.f) - log1pf(expf(-fabsf(z)));
    const int row = m0 + rsel, b = row / SEQ, s = row % SEQ;
    LF[((size_t)b * 16 + h) * SEQ + s] = lf;
    if (lane < 4) RS0[m0 + lane] = lane == 0 ? rstd[0] : lane == 1 ? rstd[1] : lane == 2 ? rstd[2] : rstd[3];
}
__device__ __forceinline__ void p0_prologue(Frame& F, const P& p) {
    bf16_t* WTA = (bf16_t*)(p.ws + WS_WTA); bf16_t* WTOA = (bf16_t*)(p.ws + WS_WTOA); bf16_t* WTB = (bf16_t*)(p.ws + WS_WTB); bf16_t* WTOB = (bf16_t*)(p.ws + WS_WTOB);
    LAS float* scr = (LAS float*)(F.lds + RING_OFF + F.wave * 8192);
    LAS float* WFl = (LAS float*)(F.lds + RING_OFF + 65536);
    const int gw = F.vcu * NWAVES + F.wave, NGW = F.G * NWAVES;
    { float wv[32], gv[32];
#pragma unroll
      for (int i = 0; i < 32; ++i) { const int e = F.tid + i * (NWAVES * 64), k = e >> 4, h = e & 15; wv[i] = p.w_in_a[(size_t)k * WINA + 3072 + h]; gv[i] = p.norm_a_g[k]; }
#pragma unroll
      for (int i = 0; i < 32; ++i) { const int e = F.tid + i * (NWAVES * 64), k = e >> 4, h = e & 15; WFl[h * 1024 + k] = gv[i] * wv[i]; } }
    __syncthreads();
    for (int rg = gw; rg < M / 4; rg += NGW) p0_rows4(F, p, rg * 4, WFl);
    constexpr int I_A = 16 * 128, I_OA = 16 * 32, I_KV = 16 * 16, I_B = 16 * 64, I_OB = 16 * 32, NITEMS = I_A + I_OA + I_KV + I_B + I_OB;
    for (int it = gw; it < NITEMS; it += NGW) {
        int r = it;
        if (r < I_A) { const int kb = r / 128, n0 = 32 * (r % 128); p0_transpose_item(p.w_in_a, WINA, n0 + (n0 >= 3072 ? 16 : 0), p.norm_a_g, WTA + (size_t)n0 * 1024, scr, 64 * kb, F.lane); continue; } r -= I_A;
        if (r < I_OA) { const int kb = r / 32, n0 = 32 * (r % 32); p0_transpose_item(p.w_out_a, 1024, n0, nullptr, WTOA + (size_t)n0 * 1024, scr, 64 * kb, F.lane); continue; } r -= I_OA;
        if (r < I_KV) { const int kb = r / 16, n0 = 32 * (r % 16); p0_transpose_item(p.w_kv, 512, n0, p.kv_norm_g, WTB + (size_t)n0 * 1024, scr, 64 * kb, F.lane); continue; } r -= I_KV;
        if (r < I_B) { const int kb = r / 64, n0 = 32 * (r % 64); p0_transpose_item(p.w_in_b, 2048, n0, p.norm_b_g, WTB + (size_t)(512 + n0) * 1024, scr, 64 * kb, F.lane); continue; } r -= I_B;
        { const int kb = r / 32, n0 = 32 * (r % 32); p0_transpose_item(p.w_out_b, 1024, n0, nullptr, WTOB + (size_t)n0 * 1024, scr, 64 * kb, F.lane); }
    }
    { const int gt = (F.G - 1 - F.vcu) * (NWAVES * 64) + F.tid;
      if (gt < 2048 * 8) { float* ROPE = (float*)(p.ws + WS_ROPE); const int s = gt >> 3, f = gt & 7; double sn, cs; sincos_d((double)p.positions[s] * p.invf[f], sn, cs); ROPE[gt] = (float)cs; ROPE[2048 * 8 + gt] = (float)sn; } }
    __syncthreads();
}
__device__ __forceinline__ void p1_scan(Frame& F, const P& p) {
    LAS double* wsum = (LAS double*)(F.lds + RING_OFF);
    const float* LF = (const float*)(p.ws + WS_LF); float* CK2 = (float*)(p.ws + WS_CK2);
    for (int job = (int)blockIdx.x; job < 2 * BATCH * NH; job += F.G) {
        const int bh = job >> 1, half = job & 1;
        const f32x4 v = *(const f32x4*)(LF + (size_t)bh * SEQ + F.tid * 4);
        const double l0 = (double)v[0], l1 = l0 + (double)v[1], l2 = l1 + (double)v[2], l3 = l2 + (double)v[3]; double incl = l3;
#pragma unroll
        for (int o = 1; o < 64; o <<= 1) { const double t = __shfl_up(incl, o); if (F.lane >= o) incl += t; }
        if (F.lane == 63) wsum[F.wave] = incl;
        __syncthreads();
        double base = 0.0;
#pragma unroll
        for (int w = 0; w < NWAVES; ++w) { const double t = wsum[w]; if (w < F.wave) base += t; }
        const double excl = base + incl - l3, L2E = 1.4426950408889634;
        if ((F.tid >> 8) == half) *(f32x4*)(CK2 + (size_t)bh * SEQ + F.tid * 4) = (f32x4){(float)((excl + l0) * L2E), (float)((excl + l1) * L2E), (float)((excl + l2) * L2E), (float)((excl + l3) * L2E)};
        __syncthreads();
    }
}
template <int MODE> __device__ __forceinline__ attn_body::AUnit attn_unit_of(int pv, int i) {
    attn_body::AUnit u;
    if (MODE == 0) { const int bh = pv >> 1, s = pv & 1, qb = (i == 0) ? s : (i == 1) ? 3 - s : (i == 2) ? 4 + s : 7 - s;
        u.b = bh >> 4; u.kvh = bh & 15; u.hq = bh & 15; u.q0 = 256 * qb; u.T0 = 0; }
    else { const int j = pv & 7, kvh = (pv >> 3) & 3, b = pv >> 5, qb = 2 * j + (i >> 1), hp = i & 1;
        u.b = b; u.kvh = kvh; u.hq = kvh * 4 + hp * 2; u.q0 = 128 * qb; u.T0 = qb > 0 ? 2 * qb - 2 : 0; }
    return u;
}
template <int MODE> __device__ __forceinline__ void attn_phase(Frame& F, const P& p, char* lds, bool dry) {
    typedef attn_body::bf16 abf;
    abf* Q = (abf*)(p.ws + (MODE ? WS_K0 : WS_Q0)); const abf* K = (const abf*)(p.ws + (MODE ? WS_G0 : WS_K0)); const abf* V = (const abf*)(p.ws + (MODE ? WS_G0 + 8 * MiB : WS_V0)); const abf* G = (const abf*)(p.ws + (MODE ? WS_V0 : WS_G0));
    abf* O = dry ? (abf*)(p.ws + WS_DUMMY) : Q;
    const float* ckb = (const float*)(p.ws + WS_CK2);
    attn_body::bf16x8 qr[4];
    const int n_units = F.vcu < 256 ? 4 * ((255 - F.vcu) / F.G + 1) : 0;
#pragma unroll 1
    for (int k = 0; k < n_units; ++k) {
        const int pv = F.vcu + (k >> 2) * F.G, pvn = F.vcu + ((k + 1) >> 2) * F.G;
        const attn_body::AUnit u = attn_unit_of<MODE>(pv, k & 3), un = attn_unit_of<MODE>(pvn, (k + 1) & 3);
        attn_body::attn_unit<MODE>(u, un, k > 0, k + 1 < n_units, qr, Q, K, V, G, O, ckb, p.sinks, lds);
    }
}

#ifndef PROBE_PHASE
#define PROBE_PHASE (-1)
#endif
#ifndef PROBE_REPS
#define PROBE_REPS 0
#endif
#define REPLOOP(k) for (int rep_ = (PROBE_PHASE == (k)) ? -(PROBE_REPS) : 0; rep_ <= 0; ++rep_)
#define DRY (rep_ < 0)
#define REPSEAM(k) do { if (DRY) xcd_barrier(bar); else SEAM(k); } while (0)
struct Args { P p; int ph_lo, ph_hi, li, pad; };
__global__ void __launch_bounds__(NWAVES * 64, 2) mk_fwd(Args args) {
    extern __shared__ __attribute__((aligned(16))) unsigned char lds[];
    const P& p = args.p;
    Frame F;
    F.lds = (LAS unsigned char*)lds;
    F.MISC = (volatile LAS unsigned*)(F.lds + MISC_OFF);
    F.tid = threadIdx.x; F.lane = F.tid & 63; F.wave = __builtin_amdgcn_readfirstlane(F.tid >> 6);
    F.G = gridDim.x; { const int bx = blockIdx.x; F.vcu = (F.G % 8 == 0) ? (bx % 8) * (F.G / 8) + bx / 8 : bx; }
    F.ctl = (gu32*)(p.ws + WS_CTL);
    for (int u = F.tid; u < (XCH_OFF - LDSCTL_OFF) / 4; u += NWAVES * 64) ((LAS unsigned*)(F.lds + LDSCTL_OFF))[u] = 0u;
    __syncthreads();
    const int lo = args.ph_lo, hi = args.ph_hi;
    XcdBarrier bar; bar.bar = (unsigned*)(F.ctl + CW_BAR) + args.li * XCD_BAR_WORDS; bar.x = 0; bar.st = nullptr;
    if (hi - lo > 1 || PROBE_REPS > 0) bar = xcd_barrier_post((unsigned*)(F.ctl + CW_BAR) + args.li * XCD_BAR_WORDS, F.MISC + 8);
#ifndef PHASE_MASK
#define PHASE_MASK 127
#endif
#define IN(k) (((PHASE_MASK >> (k)) & 1) && lo <= (k) && (k) < hi)
#define SEAM(k) do { if (IN(k) && IN((k) + 1)) xcd_barrier(bar); } while (0)
    PG8_LAS float* xch = (PG8_LAS float*)(F.lds + XCH_OFF);

    if (IN(0)) REPLOOP(0) { p0_prologue(F, p); REPSEAM(0); }

    if (IN(1)) REPLOOP(1) {
        p1_scan(F, p);
        pg8::Gemm g{(const pg8::bf16_t*)(p.ws + WS_XB), (const pg8::bf16_t*)(p.ws + WS_WTA), M, NA, 1024}; pg8::StaticOrder S; S.init(M, NA, F.G, (int)blockIdx.x);
        pg8::EpiProj<0> E{(const float*)(p.ws + WS_RS0), p.qnorm_a_g, p.knorm_a_g, nullptr, (pg8::bf16_t*)(p.ws + WS_Q0), xch};
        pg8::gemm_phase<pg8::EpiProj<0>, pg8::StaticOrder, true, true>(F.lds + RING_OFF, g, S, E);
        REPSEAM(1);
    }
    if (IN(2)) { static_assert(attn_body::ATTN_LDS_BYTES <= RING_BYTES, "attention body geometry vs frame"); REPLOOP(2) { attn_phase<0>(F, p, (char*)lds + RING_OFF, DRY); REPSEAM(2); } }
    if (IN(3)) REPLOOP(3) {
        pg8::Gemm g{(const pg8::bf16_t*)(p.ws + WS_Q0), (const pg8::bf16_t*)(p.ws + WS_WTOA), M, 1024, 1024}; pg8::StaticOrder S; S.init(M, 1024, F.G, (int)blockIdx.x);
        pg8::EpiRes1 E{p.x, p.out, (pg8::bf16_t*)(p.ws + WS_XB), (float*)(p.ws + WS_SS1)};
        pg8::gemm_phase<pg8::EpiRes1, pg8::StaticOrder, false, true>(F.lds + RING_OFF, g, S, E);
        REPSEAM(3);
    }
    if (IN(4)) REPLOOP(4) {
        pg8::Gemm g{(const pg8::bf16_t*)(p.ws + WS_XB), (const pg8::bf16_t*)(p.ws + WS_WTB), M, NB, 1024}; pg8::StaticOrder S; S.init(M, NB, F.G, (int)blockIdx.x);
        pg8::EpiProj<1> E{(const float*)(p.ws + WS_SS1), p.qnorm_b_g, p.knorm_b_g, (const float*)(p.ws + WS_ROPE), (pg8::bf16_t*)(p.ws + WS_K0), xch};
        static_assert(WS_K0 - WS_Q0 == 32 * MiB && WS_V0 - WS_K0 == 32 * MiB && WS_G0 - WS_V0 == 32 * MiB, "EpiProj's output offsets");
        pg8::gemm_phase<pg8::EpiProj<1>, pg8::StaticOrder, true, true>(F.lds + RING_OFF, g, S, E);
        REPSEAM(4);
    }
    if (IN(5)) REPLOOP(5) { attn_phase<1>(F, p, (char*)lds + RING_OFF, DRY); REPSEAM(5); }
    if (IN(6)) REPLOOP(6) {
        pg8::Gemm g{(const pg8::bf16_t*)(p.ws + WS_K0), (const pg8::bf16_t*)(p.ws + WS_WTOB), M, 1024, 1024}; pg8::StaticOrder S; S.init(M, 1024, F.G, (int)blockIdx.x);
        pg8::EpiRes2 E{DRY ? (float*)(p.ws + WS_DUMMY) : p.out};
        pg8::gemm_phase<pg8::EpiRes2, pg8::StaticOrder, false, true>(F.lds + RING_OFF, g, S, E);
        if (DRY) xcd_barrier(bar);
    }
#undef IN
#undef SEAM
}

#ifndef MK_CUTS
#define MK_CUTS 0
#endif
#ifndef NAIVE_MASK
#define NAIVE_MASK 0
#endif
extern "C" void kernel_launch(void* const* d_in, const int* in_sizes, int n_in, void* d_out, int out_size, void* d_ws, size_t ws_size, hipStream_t stream) {
    static int grid = 0;
    if (grid == 0) {
        if (n_in != 16 || out_size != M * DM || ws_size < WS_DUMMY + 64 * MiB) { fprintf(stderr, "kernel_launch: unexpected shapes (n_in %d out %d ws %zu); nothing launched\n", n_in, out_size, ws_size); grid = -1; return; }
        int dev = 0, cus = 0, per_cu = 0;
        if (hipGetDevice(&dev) != hipSuccess || hipDeviceGetAttribute(&cus, hipDeviceAttributeMultiprocessorCount, dev) != hipSuccess) { fprintf(stderr, "kernel_launch: hipGetDevice / hipDeviceGetAttribute failed\n"); grid = -1; return; }
        if (hipFuncSetAttribute((const void*)mk_fwd, hipFuncAttributeMaxDynamicSharedMemorySize, LDS_BYTES) != hipSuccess) { fprintf(stderr, "kernel_launch: hipFuncSetAttribute failed\n"); grid = -1; return; }
        if (hipOccupancyMaxActiveBlocksPerMultiprocessor(&per_cu, (const void*)mk_fwd, NWAVES * 64, LDS_BYTES) != hipSuccess || per_cu < 1)
            fprintf(stderr, "kernel_launch: note: the occupancy query reports %d workgroups per CU\n", per_cu);
        (void)hipGetLastError();
        grid = cus;
        if (grid != 256) fprintf(stderr, "kernel_launch: %d CUs; this kernel is built for 256 (one 256x256 unit per workgroup in the out-projection phases)\n", grid);
    }
    if (grid < 0) return;
    if (hipMemsetAsync((char*)d_ws + WS_CTL, 0, CTL_ZERO_BYTES, stream) != hipSuccess) { fprintf(stderr, "kernel_launch: hipMemsetAsync of the control words failed\n"); return; }
    Args a{};
    P& p = a.p;
    p.x = (const float*)d_in[0]; p.positions = (const int*)d_in[1]; p.norm_a_g = (const float*)d_in[2]; p.w_in_a = (const float*)d_in[3]; p.b_forget = (const float*)d_in[4];
    p.qnorm_a_g = (const float*)d_in[5]; p.knorm_a_g = (const float*)d_in[6]; p.w_out_a = (const float*)d_in[7]; p.kv_norm_g = (const float*)d_in[8]; p.w_kv = (const float*)d_in[9];
    p.knorm_b_g = (const float*)d_in[10]; p.norm_b_g = (const float*)d_in[11]; p.w_in_b = (const float*)d_in[12]; p.qnorm_b_g = (const float*)d_in[13]; p.sinks = (const float*)d_in[14];
    p.w_out_b = (const float*)d_in[15]; p.out = (float*)d_out; p.ws = (unsigned char*)d_ws;
    for (int i = 0; i < 8; ++i) p.invf[i] = std::pow(500000.0, -(double)i / 8.0);
    int lo = 0, li = 0;
    for (int ph = 0; ph < N_PHASES; ++ph) {
        const bool naive = (NAIVE_MASK >> ph) & 1;
        if (naive) {
            switch (ph) {
                case 0: k_prep_weights<<<2048, 256, 0, stream>>>(p); k_prep_x<<<M / 4, 256, 0, stream>>>(p); break;
                case 1: k_scan<<<BATCH * NH, 256, 0, stream>>>(p); k_gemm_naive<0><<<dim3(NA / 64, M / 64), 256, 0, stream>>>(p); break;
                case 2: k_attn_naive<0><<<dim3(SEQ / 64, BATCH * NH), 256, 0, stream>>>(p); break;
                case 3: k_gemm_naive<1><<<dim3(1024 / 64, M / 64), 256, 0, stream>>>(p); k_rowstat<<<M / 4, 256, 0, stream>>>(p); break;
                case 4: k_gemm_naive<2><<<dim3(NB / 64, M / 64), 256, 0, stream>>>(p); break;
                case 5: k_attn_naive<1><<<dim3(SEQ / 64, BATCH * NH), 256, 0, stream>>>(p); break;
                default: k_gemm_naive<3><<<dim3(1024 / 64, M / 64), 256, 0, stream>>>(p); break;
            }
            lo = ph + 1; continue;
        }
        const bool cut_after = (ph == N_PHASES - 1) || ((MK_CUTS >> ph) & 1) || ((NAIVE_MASK >> (ph + 1)) & 1);
        if (cut_after) {
            a.ph_lo = lo; a.ph_hi = ph + 1; a.li = li++;
            hipLaunchKernelGGL(mk_fwd, dim3(grid), dim3(NWAVES * 64), LDS_BYTES, stream, a);
            const hipError_t le = hipPeekAtLastError();
            if (le != hipSuccess) { fprintf(stderr, "kernel_launch: launch of phases [%d,%d) failed: %s\n", lo, ph + 1, hipGetErrorName(le)); break; }
            lo = ph + 1;
        }
    }
}
```

```cpp
#define MK_CUTS 0
#define NAIVE_MASK 0
#include <hip/hip_runtime.h>
#include <stdint.h>
#include <cstdio>
#include <cmath>

typedef unsigned short bf16_t;
typedef short bf16x8 __attribute__((ext_vector_type(8)));
typedef float f32x4 __attribute__((ext_vector_type(4)));

constexpr int BATCH = 8, SEQ = 2048, DM = 1024, NH = 16, HD = 64, M = BATCH * SEQ;
constexpr int KVW = 256;
constexpr int NA = 4096;
constexpr int NB = 2560;
constexpr int WINA = 4112;
constexpr float EPS = 1e-6f;
constexpr float LOG2E = 1.4426950408889634f;
constexpr float C2 = 0.125f * LOG2E;

constexpr size_t MiB = 1u << 20;
constexpr size_t WS_CTL = 0;
constexpr size_t WS_WTA = 2 * MiB;
constexpr size_t WS_WTOA = 10 * MiB;
constexpr size_t WS_WTB = 12 * MiB;
constexpr size_t WS_WTOB = 17 * MiB;
constexpr size_t WS_WF = 19 * MiB;
constexpr size_t WS_ROPE = 19 * MiB + 65536;
constexpr size_t WS_RS0 = 20 * MiB;
constexpr size_t WS_SS1 = 20 * MiB + 65536;
constexpr size_t WS_LF = 21 * MiB;
constexpr size_t WS_CK2 = 22 * MiB;
constexpr size_t WS_XB = 24 * MiB;
constexpr size_t WS_Q0 = 56 * MiB;
constexpr size_t WS_K0 = 88 * MiB;
constexpr size_t WS_V0 = 120 * MiB;
constexpr size_t WS_G0 = 152 * MiB;
constexpr size_t WS_END = 184 * MiB;

struct P {
    const float* x; const int* positions; const float* norm_a_g; const float* w_in_a; const float* b_forget; const float* qnorm_a_g; const float* knorm_a_g;
    const float* w_out_a; const float* kv_norm_g; const float* w_kv; const float* knorm_b_g; const float* norm_b_g; const float* w_in_b; const float* qnorm_b_g;
    const float* sinks; const float* w_out_b;
    float* out; unsigned char* ws;
    double invf[8];
};

__device__ __forceinline__ unsigned f2bf(float f) { unsigned u = __builtin_bit_cast(unsigned, f); return (u + 0x7fffu + ((u >> 16) & 1u)) >> 16; }
__device__ __forceinline__ float bf2f(unsigned short h) { return __builtin_bit_cast(float, (unsigned)h << 16); }
__device__ __forceinline__ float wave_sum(float v) {
#pragma unroll
    for (int o = 1; o < 64; o <<= 1) v += __shfl_xor(v, o);
    return v;
}
__device__ __forceinline__ float silu_f(float v) { return v / (1.0f + __expf(-v)); }

__device__ __forceinline__ void sincos_d(double a, double& s, double& c) {
    const double TWO_PI = 6.283185307179586476925, INV = 0.15915494309189533577;
    const double n = rint(a * INV);
    const double r = fma(-n, TWO_PI, a), z = r * r;
    double ps = 1.0 / 8841761993739701954543616000000.0, pc = 1.0 / 304888344611713860501504000000.0;
    const double cs[14] = { -1.0 / 10888869450418352160768000000.0, 1.0 / 15511210043330985984000000.0, -1.0 / 25852016738884976640000.0, 1.0 / 51090942171709440000.0, -1.0 / 121645100408832000.0, 1.0 / 355687428096000.0, -1.0 / 1307674368000.0, 1.0 / 6227020800.0, -1.0 / 39916800.0, 1.0 / 362880.0, -1.0 / 5040.0, 1.0 / 120.0, -1.0 / 6.0, 1.0 / 1.0 };
    const double cc[14] = { -1.0 / 403291461126605635584000000.0, 1.0 / 620448401733239439360000.0, -1.0 / 1124000727777607680000.0, 1.0 / 2432902008176640000.0, -1.0 / 6402373705728000.0, 1.0 / 20922789888000.0, -1.0 / 87178291200.0, 1.0 / 479001600.0, -1.0 / 3628800.0, 1.0 / 40320.0, -1.0 / 720.0, 1.0 / 24.0, -1.0 / 2.0, 1.0 / 1.0 };
#pragma unroll
    for (int k = 0; k < 14; ++k) { ps = fma(ps, z, cs[k]); pc = fma(pc, z, cc[k]); }
    s = ps * r; c = pc;
}
__global__ void __launch_bounds__(256) k_prep_weights(P p) {
    bf16_t* WTA = (bf16_t*)(p.ws + WS_WTA); bf16_t* WTOA = (bf16_t*)(p.ws + WS_WTOA); bf16_t* WTB = (bf16_t*)(p.ws + WS_WTB); bf16_t* WTOB = (bf16_t*)(p.ws + WS_WTOB);
    float* WF = (float*)(p.ws + WS_WF); float* ROPE = (float*)(p.ws + WS_ROPE);
    const size_t n0 = (size_t)NA * 1024, n1 = n0 + 16 * 1024, n2 = n1 + (size_t)1024 * 1024, n3 = n2 + (size_t)NB * 1024, n4 = n3 + (size_t)1024 * 1024, n5 = n4 + 2048 * 8;
    for (size_t i = (size_t)blockIdx.x * 256 + threadIdx.x; i < n5; i += (size_t)gridDim.x * 256) {
        if (i < n0) { const int n = (int)(i >> 10), k = (int)(i & 1023); const int col = n < 3072 ? n : n + 16; WTA[i] = (bf16_t)f2bf(p.norm_a_g[k] * p.w_in_a[(size_t)k * WINA + col]); }
        else if (i < n1) { const size_t j = i - n0; const int h = (int)(j >> 10), k = (int)(j & 1023); WF[j] = p.norm_a_g[k] * p.w_in_a[(size_t)k * WINA + 3072 + h]; }
        else if (i < n2) { const size_t j = i - n1; const int n = (int)(j >> 10), k = (int)(j & 1023); WTOA[j] = (bf16_t)f2bf(p.w_out_a[(size_t)k * 1024 + n]); }
        else if (i < n3) { const size_t j = i - n2; const int n = (int)(j >> 10), k = (int)(j & 1023);
            const float v = n < 512 ? p.kv_norm_g[k] * p.w_kv[(size_t)k * 512 + n] : p.norm_b_g[k] * p.w_in_b[(size_t)k * 2048 + (n - 512)]; WTB[j] = (bf16_t)f2bf(v); }
        else if (i < n4) { const size_t j = i - n3; const int n = (int)(j >> 10), k = (int)(j & 1023); WTOB[j] = (bf16_t)f2bf(p.w_out_b[(size_t)k * 1024 + n]); }
        else { const size_t j = i - n4; const int s = (int)(j >> 3), f = (int)(j & 7); double sn, cs; sincos_d((double)p.positions[s] * p.invf[f], sn, cs); ROPE[j] = (float)cs; ROPE[2048 * 8 + j] = (float)sn; }
    }
}

__global__ void __launch_bounds__(256) k_prep_x(P p) {
    const int wave = threadIdx.x >> 6, lane = threadIdx.x & 63, m = blockIdx.x * 4 + wave;
    const float* WF = (const float*)(p.ws + WS_WF); bf16_t* XB = (bf16_t*)(p.ws + WS_XB); float* RS0 = (float*)(p.ws + WS_RS0); float* LF = (float*)(p.ws + WS_LF);
    const f32x4* xr = (const f32x4*)(p.x + (size_t)m * 1024);
    f32x4 v[4]; float ss = 0.f;
#pragma unroll
    for (int j = 0; j < 4; ++j) { v[j] = xr[lane + 64 * j]; ss += (v[j].x * v[j].x + v[j].y * v[j].y) + (v[j].z * v[j].z + v[j].w * v[j].w); }
    ss = wave_sum(ss);
    const float rstd = 1.0f / sqrtf(ss * (1.0f / 1024.0f) + EPS);
#pragma unroll
    for (int j = 0; j < 4; ++j) { uint2 o; o.x = f2bf(v[j].x) | (f2bf(v[j].y) << 16); o.y = f2bf(v[j].z) | (f2bf(v[j].w) << 16); *(uint2*)(XB + (size_t)m * 1024 + 4 * (lane + 64 * j)) = o; }
    float mine = 0.f;
#pragma unroll 1
    for (int h = 0; h < 16; ++h) {
        const f32x4* wr = (const f32x4*)(WF + h * 1024); float a = 0.f;
#pragma unroll
        for (int j = 0; j < 4; ++j) { const f32x4 w = wr[lane + 64 * j]; a += (v[j].x * w.x + v[j].y * w.y) + (v[j].z * w.z + v[j].w * w.w); }
        a = wave_sum(a); if (lane == h) mine = a;
    }
    if (lane < 16) { const float z = mine * rstd + p.b_forget[lane]; const float lf = fminf(z, 0.f) - log1pf(expf(-fabsf(z))); const int b = m / SEQ, s = m % SEQ; LF[((size_t)b * 16 + lane) * SEQ + s] = lf; }
    if (lane == 0) RS0[m] = rstd;
}

__global__ void __launch_bounds__(256) k_scan(P p) {
    __shared__ double wsum[4];
    const float* LF = (const float*)(p.ws + WS_LF); float* CK2 = (float*)(p.ws + WS_CK2);
    const int bh = blockIdx.x, tid = threadIdx.x, lane = tid & 63, wave = tid >> 6;
    const float* src = LF + (size_t)bh * SEQ + tid * 8;
    double loc[8]; double run = 0.0;
#pragma unroll
    for (int i = 0; i < 8; ++i) { run += (double)src[i]; loc[i] = run; }
    double incl = run;
#pragma unroll
    for (int o = 1; o < 64; o <<= 1) { const double t = __shfl_up(incl, o); if (lane >= o) incl += t; }
    if (lane == 63) wsum[wave] = incl;
    __syncthreads();
    double base = 0.0;
    for (int w = 0; w < wave; ++w) base += wsum[w];
    const double excl = base + incl - run;
#pragma unroll
    for (int i = 0; i < 8; ++i) CK2[(size_t)bh * SEQ + tid * 8 + i] = (float)((excl + loc[i]) * 1.4426950408889634);
}

template <int EPI> __global__ void __launch_bounds__(256) k_gemm_naive(P p) {
    const int wave = threadIdx.x >> 6, lane = threadIdx.x & 63, fr = lane & 15, fq = lane >> 4;
    const int row0 = 64 * blockIdx.y + 16 * wave, col0 = 64 * blockIdx.x, hb = blockIdx.x;
    const bf16_t* Ab = (const bf16_t*)(p.ws + (EPI == 0 ? WS_XB : EPI == 1 ? WS_Q0 : EPI == 2 ? WS_XB : WS_K0));
    const bf16_t* Bb = (const bf16_t*)(p.ws + (EPI == 0 ? WS_WTA : EPI == 1 ? WS_WTOA : EPI == 2 ? WS_WTB : WS_WTOB));
    const bf16_t* A = Ab + (size_t)(row0 + fr) * 1024 + 8 * fq;
    const bf16_t* B = Bb + (size_t)(col0 + fr) * 1024 + 8 * fq;
    f32x4 acc[4];
#pragma unroll
    for (int j = 0; j < 4; ++j) acc[j] = (f32x4){0.f, 0.f, 0.f, 0.f};
#pragma unroll 2
    for (int k0 = 0; k0 < 1024; k0 += 32) {
        const bf16x8 a = *(const bf16x8*)(A + k0);
#pragma unroll
        for (int j = 0; j < 4; ++j) { const bf16x8 b = *(const bf16x8*)(B + (size_t)16 * j * 1024 + k0); acc[j] = __builtin_amdgcn_mfma_f32_16x16x32_bf16(a, b, acc[j], 0, 0, 0); }
    }
    const float* ROPE = (const float*)(p.ws + WS_ROPE);
#pragma unroll
    for (int i = 0; i < 4; ++i) {
        const int r = row0 + 4 * fq + i;
        float v[4];
#pragma unroll
        for (int j = 0; j < 4; ++j) v[j] = acc[j][i];
        if (EPI == 0) {
            const float rs = ((const float*)(p.ws + WS_RS0))[r];
#pragma unroll
            for (int j = 0; j < 4; ++j) v[j] *= rs;
            if (hb < 32) {
                float ss = (v[0] * v[0] + v[1] * v[1]) + (v[2] * v[2] + v[3] * v[3]);
                ss += __shfl_xor(ss, 1); ss += __shfl_xor(ss, 2); ss += __shfl_xor(ss, 4); ss += __shfl_xor(ss, 8);
                const float hr = 1.0f / sqrtf(ss * (1.0f / 64.0f) + EPS);
                const float* g = hb < 16 ? p.qnorm_a_g : p.knorm_a_g; const float sc = hb < 16 ? C2 : 1.0f;
                bf16_t* dst = (bf16_t*)(p.ws + (hb < 16 ? WS_Q0 : WS_K0)) + (size_t)r * 1024 + (hb & 15) * 64;
#pragma unroll
                for (int j = 0; j < 4; ++j) dst[16 * j + fr] = (bf16_t)f2bf(v[j] * hr * g[16 * j + fr] * sc);
            } else if (hb < 48) {
                bf16_t* dst = (bf16_t*)(p.ws + WS_V0) + (size_t)r * 1024 + (hb - 32) * 64;
#pragma unroll
                for (int j = 0; j < 4; ++j) dst[16 * j + fr] = (bf16_t)f2bf(v[j]);
            } else {
                bf16_t* dst = (bf16_t*)(p.ws + WS_G0) + (size_t)r * 1024 + (hb - 48) * 64;
#pragma unroll
                for (int j = 0; j < 4; ++j) dst[16 * j + fr] = (bf16_t)f2bf(silu_f(v[j]));
            }
        } else if (EPI == 1) {
            bf16_t* HB = (bf16_t*)(p.ws + WS_XB);
#pragma unroll
            for (int j = 0; j < 4; ++j) { const size_t o = (size_t)r * 1024 + col0 + 16 * j + fr; const float h1 = p.x[o] + v[j]; p.out[o] = h1; HB[o] = (bf16_t)f2bf(h1); }
        } else if (EPI == 2) {
            const f32x4 pp = *(const f32x4*)((const float*)(p.ws + WS_SS1) + (size_t)r * 4);
            const float rs = 1.0f / sqrtf(((pp.x + pp.y) + (pp.z + pp.w)) * (1.0f / 1024.0f) + EPS);
#pragma unroll
            for (int j = 0; j < 4; ++j) v[j] *= rs;
            const bool isk = hb < 4, isq = hb >= 8 && hb < 24;
            if (isk || isq) {
                float ss = (v[0] * v[0] + v[1] * v[1]) + (v[2] * v[2] + v[3] * v[3]);
                ss += __shfl_xor(ss, 1); ss += __shfl_xor(ss, 2); ss += __shfl_xor(ss, 4); ss += __shfl_xor(ss, 8);
                const float hr = 1.0f / sqrtf(ss * (1.0f / 64.0f) + EPS);
                const float* g = isk ? p.knorm_b_g : p.qnorm_b_g; const float sc = isk ? 1.0f : C2;
                float y[4];
#pragma unroll
                for (int j = 0; j < 4; ++j) y[j] = v[j] * hr * g[16 * j + fr];
                { const float partner = __shfl_xor(y[0], 8); const int s = r % SEQ, f = fr & 7; const float cs = ROPE[s * 8 + f], sn = ROPE[2048 * 8 + s * 8 + f];
                  y[0] = fr < 8 ? y[0] * cs - partner * sn : partner * sn + y[0] * cs; }
                bf16_t* dst = isk ? (bf16_t*)(p.ws + WS_G0) + (size_t)r * KVW + hb * 64 : (bf16_t*)(p.ws + WS_K0) + (size_t)r * 1024 + (hb - 8) * 64;
#pragma unroll
                for (int j = 0; j < 4; ++j) dst[16 * j + fr] = (bf16_t)f2bf(y[j] * sc);
            } else if (hb < 8) {
                bf16_t* dst = (bf16_t*)(p.ws + WS_G0 + 8 * MiB) + (size_t)r * KVW + (hb - 4) * 64;
#pragma unroll
                for (int j = 0; j < 4; ++j) dst[16 * j + fr] = (bf16_t)f2bf(v[j]);
            } else {
                bf16_t* dst = (bf16_t*)(p.ws + WS_V0) + (size_t)r * 1024 + (hb - 24) * 64;
#pragma unroll
                for (int j = 0; j < 4; ++j) dst[16 * j + fr] = (bf16_t)f2bf(silu_f(v[j]));
            }
        } else {
#pragma unroll
            for (int j = 0; j < 4; ++j) { const size_t o = (size_t)r * 1024 + col0 + 16 * j + fr; p.out[o] = p.out[o] + v[j]; }
        }
    }
}

__global__ void __launch_bounds__(256) k_rowstat(P p) {
    const int wave = threadIdx.x >> 6, lane = threadIdx.x & 63, m = blockIdx.x * 4 + wave;
    const f32x4* xr = (const f32x4*)(p.out + (size_t)m * 1024); float ss = 0.f;
#pragma unroll
    for (int j = 0; j < 4; ++j) { const f32x4 v = xr[lane + 64 * j]; ss += (v.x * v.x + v.y * v.y) + (v.z * v.z + v.w * v.w); }
    ss = wave_sum(ss);
    if (lane == 0) *(f32x4*)((float*)(p.ws + WS_SS1) + (size_t)m * 4) = (f32x4){ss, 0.f, 0.f, 0.f};
}

template <int MODE> __global__ void __launch_bounds__(256) k_attn_naive(P p) {
    __shared__ __attribute__((aligned(16))) bf16_t Ks[64 * 64];
    __shared__ __attribute__((aligned(16))) bf16_t Vs[64 * 64];
    __shared__ float cks[64];
    const int t = threadIdx.x, qb = blockIdx.x, bh = blockIdx.y, b = bh >> 4, h = bh & 15;
    const int kvh = MODE ? (h >> 2) : h, kvp = MODE ? KVW : 1024;
    const bf16_t* Q = (const bf16_t*)(p.ws + (MODE ? WS_K0 : WS_Q0)); bf16_t* O = (bf16_t*)(p.ws + (MODE ? WS_K0 : WS_Q0));
    const bf16_t* K = (const bf16_t*)(p.ws + (MODE ? WS_G0 : WS_K0)); const bf16_t* V = (const bf16_t*)(p.ws + (MODE ? WS_G0 + 8 * MiB : WS_V0));
    const bf16_t* G = (const bf16_t*)(p.ws + (MODE ? WS_V0 : WS_G0));
    const float* CK2 = (const float*)(p.ws + WS_CK2);
    const int qrow = qb * 64 + (t >> 2), part = t & 3;
    const size_t qoff = ((size_t)b * SEQ + qrow) * 1024 + h * 64;
    float q[64], o[64];
#pragma unroll
    for (int d = 0; d < 64; d += 8) { const bf16x8 v = *(const bf16x8*)(Q + qoff + d);
#pragma unroll
        for (int e = 0; e < 8; ++e) q[d + e] = bf2f((unsigned short)v[e]); }
#pragma unroll
    for (int d = 0; d < 64; ++d) o[d] = 0.f;
    float l = 0.f;
    const float cq = MODE == 0 ? CK2[(size_t)bh * SEQ + qrow] : 0.f;
    const int kt0 = MODE ? (qb >= 2 ? qb - 2 : 0) : 0;
    for (int kt = kt0; kt <= qb; ++kt) {
        __syncthreads();
        { const int row = t >> 2, cs = (t & 3) * 16; const size_t ko = ((size_t)b * SEQ + kt * 64 + row) * kvp + kvh * 64 + cs;
          *(bf16x8*)(Ks + row * 64 + cs) = *(const bf16x8*)(K + ko); *(bf16x8*)(Ks + row * 64 + cs + 8) = *(const bf16x8*)(K + ko + 8);
          *(bf16x8*)(Vs + row * 64 + cs) = *(const bf16x8*)(V + ko); *(bf16x8*)(Vs + row * 64 + cs + 8) = *(const bf16x8*)(V + ko + 8);
          if (MODE == 0 && t < 64) cks[t] = CK2[(size_t)bh * SEQ + kt * 64 + t]; }
        __syncthreads();
#pragma unroll 1
        for (int kk = 0; kk < 16; ++kk) {
            const int key = part * 16 + kk, kpos = kt * 64 + key;
            float s = 0.f;
#pragma unroll
            for (int d = 0; d < 64; d += 8) { const bf16x8 kv = *(const bf16x8*)(Ks + key * 64 + d);
#pragma unroll
                for (int e = 0; e < 8; ++e) s += q[d + e] * bf2f((unsigned short)kv[e]); }
            if (MODE == 0) s += cq - cks[key];
            const bool valid = kpos <= qrow && (MODE == 0 || kpos > qrow - 128);
            const float pr = valid ? __builtin_amdgcn_exp2f(s) : 0.f;
            l += pr;
#pragma unroll
            for (int d = 0; d < 64; d += 8) { const bf16x8 vv = *(const bf16x8*)(Vs + key * 64 + d);
#pragma unroll
                for (int e = 0; e < 8; ++e) o[d + e] += pr * bf2f((unsigned short)vv[e]); }
        }
    }
    l += __shfl_xor(l, 1); l += __shfl_xor(l, 2);
#pragma unroll
    for (int d = 0; d < 64; ++d) { o[d] += __shfl_xor(o[d], 1); o[d] += __shfl_xor(o[d], 2); }
    if (MODE == 1) l += __builtin_amdgcn_exp2f(p.sinks[h] * LOG2E);
    const float rl = 1.0f / l;
#pragma unroll
    for (int d = 0; d < 64; ++d) if ((d >> 4) == part) O[qoff + d] = (bf16_t)f2bf(o[d] * rl * bf2f(G[qoff + d]));
}

namespace pg8 {
#define PG8_LAS __attribute__((address_space(3)))
typedef unsigned short bf16_t;
typedef short bf16x8 __attribute__((ext_vector_type(8)));
typedef float f32x4 __attribute__((ext_vector_type(4)));
typedef unsigned u32x4 __attribute__((ext_vector_type(4)));
constexpr int BM = 256, BK = 64, HALF = 128, HTB = HALF * BK * 2  , STAGE_BYTES = 8 * HTB, NXCD = 8, WGM = 8;

__host__ __device__ __forceinline__ int lds_byte(int r, int c) { const int st = (r >> 4) * 2 + (c >> 5), rr = r & 15, cc = c & 31, ob = rr * 64 + cc * 2; return st * 1024 + (ob ^ (((ob >> 9) & 1) << 5)); }
__host__ __device__ __forceinline__ void stage_rc(int b, int& R, int& C) { const int st = b / 1024, sb = b % 1024, swz = sb ^ (((sb >> 9) & 1) << 5); R = (st >> 1) * 16 + swz / 64; C = (st & 1) * 32 + (swz % 64) / 2; }
__host__ __device__ __forceinline__ int perm32(int rho) { const int n = rho >> 4, i = rho & 15; return 8 * (i >> 2) + 4 * n + (i & 3); }

struct Unit { int pm, pn; };
struct Gemm { const bf16_t* A; const bf16_t* Bt; int M, N, K; };

struct StaticOrder {
    int nM, nN, nwg, G, c;
    __host__ __device__ void init(int M, int N, int G_, int c_) { nM = M / BM; nN = N / BM; nwg = nM * nN; G = G_; c = c_; }
    __host__ __device__ bool next(int i, Unit& u) const {
        const long L = (long)i * G + c; if (L >= nwg) return false;
        int wgid = (int)L; { const int q = nwg / NXCD, r = nwg % NXCD, xcd = wgid % NXCD, off = wgid / NXCD; wgid = (xcd < r ? xcd * (q + 1) : r * (q + 1) + (xcd - r) * q) + off; }
        const int nig = WGM * nN, gid = wgid / nig, fm = gid * WGM, gsz = (nM - fm) < WGM ? (nM - fm) : WGM;
        u.pm = fm + ((wgid % nig) % gsz); u.pn = (wgid % nig) / gsz; return true;
    }
    __device__ __forceinline__ void a_ready(const Unit&) const {}
    __device__ __forceinline__ void done(const Unit&) const {}
};


typedef float f32x2_t __attribute__((ext_vector_type(2))); typedef __bf16 bf16x2_t __attribute__((ext_vector_type(2)));
__device__ __forceinline__ unsigned cvtpk(float lo, float hi) { f32x2_t v = {lo, hi}; bf16x2_t b = __builtin_convertvector(v, bf16x2_t); return __builtin_bit_cast(unsigned, b); }
__device__ __forceinline__ float silu1(float v) { return v * __builtin_amdgcn_rcpf(1.0f + __builtin_amdgcn_exp2f(-1.4426950408889634f * v)); }
constexpr float EPI_EPS = 1e-6f, EPI_C2 = 0.125f * 1.4426950408889634f;

template <int LAYER> struct EpiProj {
    static constexpr bool PERM = true, AFTER_DRAIN = false;
    const float* rs;
    const float* gq; const float* gk; const float* rope;
    bf16_t* base;
    PG8_LAS float* xch;
    __device__ __forceinline__ void operator()(f32x4 (&acc)[2][2][4][2], const Unit& u, int wr, int wc, int fr, int fq) const {
        int kind, tcol, pitch; size_t doff;
        constexpr size_t Mi = (size_t)1 << 20;
        if (LAYER == 0) { kind = u.pn >> 2; tcol = (u.pn & 3) * 256; pitch = 1024; doff = (size_t)kind * (16 * Mi); }
        else { if (u.pn == 0) { kind = 1; tcol = 0; pitch = 256; doff = 32 * Mi; } else if (u.pn == 1) { kind = 2; tcol = 0; pitch = 256; doff = 36 * Mi; }
               else if (u.pn < 6) { kind = 0; tcol = (u.pn - 2) * 256; pitch = 1024; doff = 0; } else { kind = 3; tcol = (u.pn - 6) * 256; pitch = 1024; doff = 16 * Mi; } }
        bf16_t* dst = base + doff;
        const int rowl0 = wr * 64 + fr, row0 = u.pm * BM + rowl0;
#pragma unroll
        for (int ai = 0; ai < 2; ++ai)
#pragma unroll
            for (int m = 0; m < 4; ++m) { const int r = row0 + ai * HALF + m * 16; float rsv;
                if (LAYER == 0) rsv = rs[r]; else { const f32x4 pp = *(const f32x4*)(rs + (size_t)r * 4); rsv = 1.0f / sqrtf(((pp[0] + pp[1]) + (pp[2] + pp[3])) * (1.0f / 1024.0f) + EPI_EPS); }
#pragma unroll
                for (int bj = 0; bj < 2; ++bj) { acc[ai][bj][m][0] *= rsv; acc[ai][bj][m][1] *= rsv; } }
        bf16_t* dcol = dst + tcol + wc * 32 + 8 * fq;
        if (kind <= 1) {
#pragma unroll
            for (int ai = 0; ai < 2; ++ai)
#pragma unroll
                for (int m = 0; m < 4; ++m)
#pragma unroll
                    for (int bj = 0; bj < 2; ++bj) { const f32x4 a = acc[ai][bj][m][0], b = acc[ai][bj][m][1];
                        float ss = ((a[0] * a[0] + a[1] * a[1]) + (a[2] * a[2] + a[3] * a[3])) + ((b[0] * b[0] + b[1] * b[1]) + (b[2] * b[2] + b[3] * b[3]));
                        ss += __shfl_xor(ss, 16); ss += __shfl_xor(ss, 32);
                        if (fq == 0) xch[((ai * HALF + rowl0 + m * 16) * 2 + bj) * 4 + wc] = ss; }
            asm volatile("s_waitcnt lgkmcnt(0)" ::: "memory"); __builtin_amdgcn_s_barrier(); asm volatile("" ::: "memory");
            const float* g = kind == 0 ? gq : gk; const float sc = kind == 0 ? EPI_C2 : 1.0f;
            const int d0 = 32 * (wc & 1) + 8 * fq;
            const f32x4 g0 = *(const f32x4*)(g + d0) * sc, g1 = *(const f32x4*)(g + d0 + 4) * sc;
            const bool rot = LAYER == 1 && (wc & 1) == 0;
#pragma unroll
            for (int ai = 0; ai < 2; ++ai)
#pragma unroll
                for (int m = 0; m < 4; ++m) { const int r = row0 + ai * HALF + m * 16;
                    f32x4 cs0 = {}, cs1 = {}, sn0 = {}, sn1 = {};
                    if (rot) { const float* rp = rope + (size_t)(r & 2047) * 8; cs0 = *(const f32x4*)rp; cs1 = *(const f32x4*)(rp + 4); sn0 = *(const f32x4*)(rp + 16384); sn1 = *(const f32x4*)(rp + 16384 + 4); }
#pragma unroll
                    for (int bj = 0; bj < 2; ++bj) { const f32x2_t pr = *(const PG8_LAS f32x2_t*)(xch + ((ai * HALF + rowl0 + m * 16) * 2 + bj) * 4 + (wc & 2)); const float tot = pr[0] + pr[1];
                        const float hr = 1.0f / sqrtf(tot * (1.0f / 64.0f) + EPI_EPS);
                        f32x4 y0 = acc[ai][bj][m][0] * hr * g0, y1 = acc[ai][bj][m][1] * hr * g1;
                        if (rot) { f32x4 p0, p1;
#pragma unroll
                            for (int i = 0; i < 4; ++i) { p0[i] = __shfl_xor(y0[i], 16); p1[i] = __shfl_xor(y1[i], 16); }
                            if (fq == 0) { y0 = y0 * cs0 - p0 * sn0; y1 = y1 * cs1 - p1 * sn1; }
                            else if (fq == 1) { y0 = p0 * sn0 + y0 * cs0; y1 = p1 * sn1 + y1 * cs1; } }
                        u32x4 w; w.x = cvtpk(y0[0], y0[1]); w.y = cvtpk(y0[2], y0[3]); w.z = cvtpk(y1[0], y1[1]); w.w = cvtpk(y1[2], y1[3]);
                        *(u32x4*)(dcol + (size_t)r * pitch + bj * HALF) = w; }
                    asm volatile("" ::: "memory"); }
        } else {
#pragma unroll
            for (int ai = 0; ai < 2; ++ai)
#pragma unroll
                for (int m = 0; m < 4; ++m) { const int r = row0 + ai * HALF + m * 16;
#pragma unroll
                    for (int bj = 0; bj < 2; ++bj) { f32x4 y0 = acc[ai][bj][m][0], y1 = acc[ai][bj][m][1];
                        if (kind == 3) {
#pragma unroll
                            for (int i = 0; i < 4; ++i) { y0[i] = silu1(y0[i]); y1[i] = silu1(y1[i]); } }
                        u32x4 w; w.x = cvtpk(y0[0], y0[1]); w.y = cvtpk(y0[2], y0[3]); w.z = cvtpk(y1[0], y1[1]); w.w = cvtpk(y1[2], y1[3]);
                        *(u32x4*)(dcol + (size_t)r * pitch + bj * HALF) = w; } }
        }
    }
};

struct EpiRes1 {
    static constexpr bool PERM = false, AFTER_DRAIN = true;
    static constexpr int LATE_STORES = 32;
    const float* x; float* out; bf16_t* hb; float* ss1;
    __device__ __forceinline__ void fused(f32x4 (&acc)[2][2][4][2], const Unit& u, int wr, int wc, int fr, int fq, PG8_LAS unsigned char* lds, int wid, int lane) const {
        PG8_LAS float* Pp = (PG8_LAS float*)lds;
        const int col0 = u.pn * BM + wc * 32 + 4 * fq;
#pragma unroll
        for (int ai = 0; ai < 2; ++ai)
#pragma unroll
            for (int m = 0; m < 4; ++m) { const int rl = ai * HALF + wr * 64 + m * 16 + fr; const size_t off = (size_t)(u.pm * BM + rl) * 1024 + col0; float ss = 0.f;
#pragma unroll
                for (int bj = 0; bj < 2; ++bj)
#pragma unroll
                    for (int n = 0; n < 2; ++n) { const f32x4 h = *(const f32x4*)(x + off + bj * HALF + n * 16) + acc[ai][bj][m][n]; acc[ai][bj][m][n] = h;
                        ss += (h[0] * h[0] + h[1] * h[1]) + (h[2] * h[2] + h[3] * h[3]);
                        unsigned w0 = cvtpk(h[0], h[1]), w1 = cvtpk(h[2], h[3]); *(unsigned long long*)(hb + off + bj * HALF + n * 16) = (unsigned long long)w0 | ((unsigned long long)w1 << 32); }
                ss += __shfl_xor(ss, 16); ss += __shfl_xor(ss, 32);
                if (fq == 0) Pp[rl * 4 + wc] = ss;
                if (m & 1) asm volatile("" ::: "memory"); }
        asm volatile("s_waitcnt lgkmcnt(0)" ::: "memory"); __builtin_amdgcn_s_barrier(); asm volatile("" ::: "memory");
        const int t = wid * 64 + lane;
        if (t < 256) { const f32x4 pp = *(const PG8_LAS f32x4*)(Pp + t * 4); ss1[(size_t)(u.pm * BM + t) * 4 + u.pn] = (pp[0] + pp[1]) + (pp[2] + pp[3]); }
        asm volatile("" ::: "memory");
#pragma unroll
        for (int ai = 0; ai < 2; ++ai)
#pragma unroll
            for (int m = 0; m < 4; ++m) { const size_t off = (size_t)(u.pm * BM + ai * HALF + wr * 64 + m * 16 + fr) * 1024 + col0;
#pragma unroll
                for (int bj = 0; bj < 2; ++bj)
#pragma unroll
                    for (int n = 0; n < 2; ++n) *(f32x4*)(out + off + bj * HALF + n * 16) = acc[ai][bj][m][n]; }
        asm volatile("" ::: "memory");
    }
};
struct EpiRes2 {
    static constexpr bool PERM = false, AFTER_DRAIN = true;
    float* out;
    __device__ __forceinline__ void fused(f32x4 (&acc)[2][2][4][2], const Unit& u, int wr, int wc, int fr, int fq, PG8_LAS unsigned char* lds, int wid, int lane) const {
        const int col0 = u.pn * BM + wc * 32 + 4 * fq;
#pragma unroll
        for (int ai = 0; ai < 2; ++ai)
#pragma unroll
            for (int m = 0; m < 4; ++m) { const size_t off = (size_t)(u.pm * BM + ai * HALF + wr * 64 + m * 16 + fr) * 1024 + col0;
#pragma unroll
                for (int bj = 0; bj < 2; ++bj)
#pragma unroll
                    for (int n = 0; n < 2; ++n) { float* o = out + off + bj * HALF + n * 16; *(f32x4*)o = *(const f32x4*)o + acc[ai][bj][m][n]; }
                if (m & 1) asm volatile("" ::: "memory"); }
    }
};

template <class Epi, class Sched, bool ALIGN_EPI = false, bool SP2 = false>
__device__ __forceinline__ void gemm_phase(PG8_LAS unsigned char* lds, const Gemm g, const Sched& S, const Epi& E) {
    int tid_ = threadIdx.x; asm volatile("" : "+v"(tid_));
    const int tid = tid_, wid = __builtin_amdgcn_readfirstlane(tid >> 6), lane = tid & 63, wr = wid >> 2, wc = wid & 3, fr = lane & 15, fq = lane >> 4;
    const int K = g.K, nt = K / BK;
    unsigned voffA[2], voffB[2];
#pragma unroll
    for (int i = 0; i < 2; ++i) { int R, C; stage_rc(tid * 16 + i * 8192, R, C); const int Rb = Epi::PERM ? ((R & ~31) + perm32(R & 31)) : R;
        voffA[i] = (unsigned)(R * K + C) * 2u; voffB[i] = (unsigned)(Rb * K + C) * 2u; }
    const size_t kstep = (size_t)(BK * 2);
    const size_t hstep = (size_t)HALF * K * 2;
    const size_t tstep = 2 * hstep;
    const unsigned ldsw = (unsigned)wid * 1024u;
    const int aoff = lds_byte(wr * 64 + fr, fq * 8), boff = lds_byte(wc * 32 + fr, fq * 8);
#define PG8_SA(b, h) (((b) * 2 + (h)) * HTB)
#define PG8_SB(b, h) ((4 + (b) * 2 + (h)) * HTB)
#define PG8_STAGE(bufoff, gbase, voff) do { _Pragma("unroll") for (int _i = 0; _i < 2; ++_i) \
        __builtin_amdgcn_global_load_lds((const unsigned*)((const char*)(gbase) + (voff)[_i]), (PG8_LAS unsigned*)(lds + (bufoff) + ldsw + _i * 8192), 16, 0, 0); } while (0)
#define PG8_LDA(dst, b, h) do { _Pragma("unroll") for (int m = 0; m < 4; ++m) _Pragma("unroll") for (int k = 0; k < 2; ++k) dst[m][k] = *(const PG8_LAS bf16x8*)(lds + PG8_SA(b, h) + aoff + m * 2048 + k * 1024); } while (0)
#define PG8_LDB(dst, b, h) do { _Pragma("unroll") for (int n = 0; n < 2; ++n) _Pragma("unroll") for (int k = 0; k < 2; ++k) dst[n][k] = *(const PG8_LAS bf16x8*)(lds + PG8_SB(b, h) + boff + n * 2048 + k * 1024); } while (0)
#define PG8_MMA(ai, bj, At, Bt) do { __builtin_amdgcn_s_setprio(1); _Pragma("unroll") for (int m = 0; m < 4; ++m) _Pragma("unroll") for (int n = 0; n < 2; ++n) _Pragma("unroll") for (int k = 0; k < 2; ++k) \
        acc[ai][bj][m][n] = __builtin_amdgcn_mfma_f32_16x16x32_bf16(Bt[n][k], At[m][k], acc[ai][bj][m][n], 0, 0, 0); __builtin_amdgcn_s_setprio(0); } while (0)
#define PG8_WAIT_V(n) asm volatile("s_waitcnt vmcnt(" #n ")" ::: "memory")
#define PG8_WAIT_L(n) asm volatile("s_waitcnt lgkmcnt(" #n ")" ::: "memory")
#define PG8_BAR __builtin_amdgcn_s_barrier()
#define PG8_SCHED __builtin_amdgcn_sched_barrier(0)
    Unit cur, nxt; int ui = 0;
    if (!S.next(0, cur)) return;
    f32x4 acc[2][2][4][2];
#pragma unroll
    for (int a = 0; a < 2; ++a)
#pragma unroll
        for (int b = 0; b < 2; ++b)
#pragma unroll
            for (int m = 0; m < 4; ++m)
#pragma unroll
                for (int n = 0; n < 2; ++n) acc[a][b][m][n] = (f32x4){0.f, 0.f, 0.f, 0.f};
    bf16x8 At[4][2], B0[2][2], B1[2][2];
    const char* cA = (const char*)g.A + (size_t)cur.pm * tstep; const char* cB = (const char*)g.Bt + (size_t)cur.pn * tstep;
    S.a_ready(cur);
    if constexpr (SP2) {
        PG8_STAGE(PG8_SB(0, 0), cB, voffB); PG8_STAGE(PG8_SB(0, 1), cB + hstep, voffB); PG8_STAGE(PG8_SA(0, 0), cA, voffA); PG8_STAGE(PG8_SA(0, 1), cA + hstep, voffA);
        if (wr == 1) PG8_BAR;
        PG8_WAIT_V(2); PG8_BAR;
        PG8_STAGE(PG8_SB(1, 0), cB + kstep, voffB); PG8_STAGE(PG8_SA(1, 0), cA + kstep, voffA); PG8_STAGE(PG8_SB(1, 1), cB + hstep + kstep, voffB);
        PG8_WAIT_V(6); PG8_BAR;
    } else {
        PG8_STAGE(PG8_SB(0, 0), cB, voffB); PG8_STAGE(PG8_SA(0, 0), cA, voffA); PG8_STAGE(PG8_SB(0, 1), cB + hstep, voffB); PG8_STAGE(PG8_SA(0, 1), cA + hstep, voffA);
        if (wr == 1) PG8_BAR;
        PG8_WAIT_V(4); PG8_BAR;
        PG8_STAGE(PG8_SB(1, 0), cB + kstep, voffB); PG8_STAGE(PG8_SA(1, 0), cA + kstep, voffA); PG8_STAGE(PG8_SB(1, 1), cB + hstep + kstep, voffB);
        PG8_WAIT_V(6); PG8_BAR;
    }
    for (;;) {
        const bool has_next = S.next(ui + 1, nxt);
        const char* nA = has_next ? (const char*)g.A + (size_t)nxt.pm * tstep : cA; const char* nB = has_next ? (const char*)g.Bt + (size_t)nxt.pn * tstep : cB;
        for (int t = 0; t < nt; t += 2) {
            const bool last = (t == nt - 2);
            const char* a1 = cA + (size_t)(t + 1) * kstep;
            const char* a2 = last ? nA : cA + (size_t)(t + 2) * kstep; const char* b2 = last ? nB : cB + (size_t)(t + 2) * kstep;
            const char* a3 = a2 + kstep; const char* b3 = b2 + kstep;
            if (last && has_next) S.a_ready(nxt);
            if constexpr (SP2) {
            PG8_LDB(B0, 0, 0); PG8_LDB(B1, 0, 1); PG8_SCHED; PG8_LDA(At, 0, 0); PG8_STAGE(PG8_SA(1, 1), a1 + hstep, voffA);
            PG8_WAIT_V(8); PG8_WAIT_L(0); PG8_BAR; PG8_MMA(0, 0, At, B0); PG8_MMA(0, 1, At, B1); PG8_BAR; PG8_SCHED;
            PG8_LDA(At, 0, 1); PG8_STAGE(PG8_SB(0, 0), b2, voffB); PG8_STAGE(PG8_SB(0, 1), b2 + hstep, voffB); PG8_STAGE(PG8_SA(0, 0), a2, voffA);
            PG8_WAIT_V(8); PG8_WAIT_L(0); PG8_BAR; PG8_MMA(1, 0, At, B0); PG8_MMA(1, 1, At, B1); PG8_BAR; PG8_SCHED;
            PG8_LDB(B0, 1, 0); PG8_LDB(B1, 1, 1); PG8_SCHED; PG8_LDA(At, 1, 0); PG8_STAGE(PG8_SA(0, 1), a2 + hstep, voffA);
            PG8_WAIT_V(8); PG8_WAIT_L(0); PG8_BAR; PG8_MMA(0, 0, At, B0); PG8_MMA(0, 1, At, B1); PG8_BAR; PG8_SCHED;
            PG8_LDA(At, 1, 1); PG8_STAGE(PG8_SB(1, 0), b3, voffB); PG8_STAGE(PG8_SB(1, 1), b3 + hstep, voffB); PG8_STAGE(PG8_SA(1, 0), a3, voffA);
            PG8_WAIT_V(8); PG8_WAIT_L(0); PG8_BAR; PG8_MMA(1, 0, At, B0); PG8_MMA(1, 1, At, B1); PG8_BAR; PG8_SCHED;
            } else {
            PG8_LDB(B0, 0, 0); PG8_SCHED; PG8_LDA(At, 0, 0); PG8_STAGE(PG8_SA(1, 1), a1 + hstep, voffA);
            PG8_WAIT_L(8); PG8_BAR; PG8_WAIT_L(0); PG8_MMA(0, 0, At, B0); PG8_BAR; PG8_SCHED;
            PG8_LDB(B1, 0, 1); PG8_STAGE(PG8_SB(0, 0), b2, voffB);
            PG8_BAR; PG8_WAIT_L(0); PG8_MMA(0, 1, At, B1); PG8_BAR;
            PG8_LDA(At, 0, 1); PG8_STAGE(PG8_SA(0, 0), a2, voffA);
            PG8_BAR; PG8_WAIT_L(0); PG8_MMA(1, 0, At, B0); PG8_BAR; PG8_SCHED;
            PG8_STAGE(PG8_SB(0, 1), b2 + hstep, voffB);
            PG8_WAIT_V(6); PG8_BAR; PG8_MMA(1, 1, At, B1); PG8_BAR;
            PG8_LDB(B0, 1, 0); PG8_SCHED; PG8_LDA(At, 1, 0); PG8_STAGE(PG8_SA(0, 1), a2 + hstep, voffA);
            PG8_WAIT_L(8); PG8_BAR; PG8_WAIT_L(0); PG8_MMA(0, 0, At, B0); PG8_BAR; PG8_SCHED;
            PG8_LDB(B1, 1, 1); PG8_STAGE(PG8_SB(1, 0), b3, voffB);
            PG8_BAR; PG8_WAIT_L(0); PG8_MMA(0, 1, At, B1); PG8_BAR;
            PG8_LDA(At, 1, 1); PG8_STAGE(PG8_SA(1, 0), a3, voffA);
            PG8_BAR; PG8_WAIT_L(0); PG8_MMA(1, 0, At, B0); PG8_BAR; PG8_SCHED;
            PG8_STAGE(PG8_SB(1, 1), b3 + hstep, voffB);
            PG8_WAIT_V(6); PG8_BAR; PG8_MMA(1, 1, At, B1); PG8_BAR;
            }
        }
        if constexpr (ALIGN_EPI) { if (wr == 0) PG8_BAR; }
        if constexpr (!Epi::AFTER_DRAIN) { E(acc, cur, wr, wc, fr, fq); S.done(cur); }
        if (!has_next) break;
#pragma unroll
        for (int a = 0; a < 2; ++a)
#pragma unroll
            for (int b = 0; b < 2; ++b)
#pragma unroll
                for (int m = 0; m < 4; ++m)
#pragma unroll
                    for (int n = 0; n < 2; ++n) acc[a][b][m][n] = (f32x4){0.f, 0.f, 0.f, 0.f};
        cur = nxt; cA = nA; cB = nB; ++ui;
        if constexpr (ALIGN_EPI) { if (wr == 1) PG8_BAR; }
    }
    PG8_WAIT_V(0);
    if constexpr (!ALIGN_EPI) { if (wr == 0) PG8_BAR; }
    PG8_BAR;
    if constexpr (Epi::AFTER_DRAIN) { E.fused(acc, cur, wr, wc, fr, fq, lds, wid, lane); S.done(cur); }
#undef PG8_SA
#undef PG8_SB
#undef PG8_STAGE
#undef PG8_LDA
#undef PG8_LDB
#undef PG8_MMA
#undef PG8_WAIT_V
#undef PG8_WAIT_L
#undef PG8_BAR
#undef PG8_SCHED
}
}

namespace attn_body {
using bf16 = unsigned short;
using bf16x8 = __attribute__((ext_vector_type(8))) short;
using s16x4 = __attribute__((ext_vector_type(4))) short;
using f32x16 = __attribute__((ext_vector_type(16))) float;
using f32x4 = __attribute__((ext_vector_type(4))) float;
using u32x4 = __attribute__((ext_vector_type(4))) unsigned;
constexpr int SEQ = 2048, D = 64, DM = 1024;
constexpr int NW = 8, QBLK = 32, QB = QBLK * NW, KVBLK = 64;
__device__ __forceinline__ int crow(int r, int hi) { return (r & 3) + 8 * (r >> 2) + 4 * hi; }
#define SBAR() __builtin_amdgcn_sched_barrier(0)
template <int MODE> __device__ __forceinline__ void amask(f32x16& p0, f32x16& p1, int d) {
  const float NEG = -INFINITY; asm volatile("" : "+v"(d)); const int d2 = d - 128;
  #pragma unroll
  for (int r = 0; r < 16; ++r) { const int c = (r & 3) + 8 * (r >> 2);
    if (MODE == 0) { if (c > d) p0[r] = NEG; if (c + 32 > d) p1[r] = NEG; }
    else { if (c > d || c <= d2) p0[r] = NEG; if (c + 32 > d || c + 32 <= d2) p1[r] = NEG; } }
}
constexpr int NSLOT = 3, SLOTB = 8192;
constexpr int LDS_K = 0, LDS_V = NSLOT * SLOTB, LDS_WS = 2 * NSLOT * SLOTB, LDS_BU = LDS_WS + NW * 64 * 4, LDS_OST = LDS_BU + 8192, LDS_BYTES = LDS_OST + NW * 8192;
__device__ __forceinline__ void glds16(const void* sbase, unsigned voff, unsigned lds_dst) { unsigned keep;
  asm volatile("s_nop 4\n\ts_mov_b32 %0, m0\n\ts_mov_b32 m0, %3\n\ts_nop 0\n\tglobal_load_lds_dwordx4 %1, %2\n\ts_mov_b32 m0, %0" : "=&s"(keep) : "v"(voff), "s"(sbase), "s"(lds_dst) : "memory"); }
typedef float f32x2_t __attribute__((ext_vector_type(2))); typedef __bf16 bf16x2_t __attribute__((ext_vector_type(2)));
__device__ __forceinline__ unsigned cvtpk_s(float lo, float hi) { f32x2_t v = {lo, hi}; bf16x2_t b = __builtin_convertvector(v, bf16x2_t); return __builtin_bit_cast(unsigned, b); }
#define WAIT_BAR(N) asm volatile("s_waitcnt vmcnt(" #N ") lgkmcnt(0)\n\ts_barrier" ::: "memory")
typedef __attribute__((address_space(3))) const char* lds_cptr;
typedef short v4i16_t __attribute__((ext_vector_type(4)));
__device__ __forceinline__ void kload8(bf16x8* kf, lds_cptr kp) {
  kf[0] = *(const __attribute__((address_space(3))) bf16x8*)(kp);        kf[1] = *(const __attribute__((address_space(3))) bf16x8*)(kp + 512);
  kf[2] = *(const __attribute__((address_space(3))) bf16x8*)(kp + 2048); kf[3] = *(const __attribute__((address_space(3))) bf16x8*)(kp + 2560);
  kf[4] = *(const __attribute__((address_space(3))) bf16x8*)(kp + 4096); kf[5] = *(const __attribute__((address_space(3))) bf16x8*)(kp + 4608);
  kf[6] = *(const __attribute__((address_space(3))) bf16x8*)(kp + 6144); kf[7] = *(const __attribute__((address_space(3))) bf16x8*)(kp + 6656);
}
__device__ __forceinline__ void kload2(bf16x8* kf, lds_cptr kp, int j) { kf[2 * j] = *(const __attribute__((address_space(3))) bf16x8*)(kp + j * 2048); kf[2 * j + 1] = *(const __attribute__((address_space(3))) bf16x8*)(kp + j * 2048 + 512); }
__device__ __forceinline__ s16x4 vtr(lds_cptr p) { return __builtin_bit_cast(s16x4, __builtin_amdgcn_ds_read_tr16_b64_v4i16((__attribute__((address_space(3))) v4i16_t*)p)); }
__device__ __forceinline__ void pv(f32x16* o, int vb, bf16x8 pa0, bf16x8 pa1, bf16x8 pa2, bf16x8 pa3) {
  #pragma unroll
  for (int d0 = 0; d0 < 2; ++d0) { s16x4 lo[4], hi[4];
    #pragma unroll
    for (int ks = 0; ks < 4; ++ks) {
      asm volatile("ds_read_b64_tr_b16 %0,%1 offset:%c2" : "=&v"(lo[ks]) : "v"(vb), "i"(d0 * 4096 + ks * 1024) : "memory");
      asm volatile("ds_read_b64_tr_b16 %0,%1 offset:%c2" : "=&v"(hi[ks]) : "v"(vb), "i"(d0 * 4096 + ks * 1024 + 512) : "memory"); }
    asm volatile("s_waitcnt lgkmcnt(0)" ::: "memory"); SBAR();
    #define PK(k) (bf16x8){lo[k][0], lo[k][1], lo[k][2], lo[k][3], hi[k][0], hi[k][1], hi[k][2], hi[k][3]}
    o[d0] = __builtin_amdgcn_mfma_f32_32x32x16_bf16(pa0, PK(0), o[d0], 0, 0, 0);
    o[d0] = __builtin_amdgcn_mfma_f32_32x32x16_bf16(pa1, PK(1), o[d0], 0, 0, 0);
    o[d0] = __builtin_amdgcn_mfma_f32_32x32x16_bf16(pa2, PK(2), o[d0], 0, 0, 0);
    o[d0] = __builtin_amdgcn_mfma_f32_32x32x16_bf16(pa3, PK(3), o[d0], 0, 0, 0);
    #undef PK
  }
}

struct AUnit { int b, kvh, hq, q0, T0; };
template <int MODE> __device__ __forceinline__ void attn_unit(const AUnit u, const AUnit un, bool has_prev, bool has_next, bf16x8 (&qr)[4], const bf16* Q, const bf16* __restrict__ K, const bf16* __restrict__ V, const bf16* __restrict__ G, bf16* O, const float* ckb, const float* sinks, char* shm) {
  constexpr int KP = MODE ? 256 : 1024;
  constexpr int QROWS = MODE ? 128 : 256;
  int tid_ = threadIdx.x; asm volatile("" : "+v"(tid_));
  const int tid = tid_, lane = tid & 63, r32 = lane & 31, hi = lane >> 5; const int wid = __builtin_amdgcn_readfirstlane(tid >> 6);
  const int hw = MODE ? u.hq + (wid >> 2) : u.hq, rw = MODE ? 32 * (wid & 3) : 32 * wid;
  const long rowbase = (long)u.b * SEQ; const int q0 = u.q0, T0 = u.T0;
  const int NT = (q0 + QROWS) / KVBLK - T0;
  const bf16* Kh = K + (rowbase + (long)T0 * KVBLK) * KP + u.kvh * D, *Vh = V + (rowbase + (long)T0 * KVBLK) * KP + u.kvh * D;
  const unsigned lds0 = (unsigned)(uintptr_t)shm;
  const lds_cptr shm3 = (lds_cptr)shm;
  const unsigned koff = (unsigned)(lane * KP + wid * 8) * 2u;
  const unsigned voff = (unsigned)((16 * (wid & 3) + (lane >> 2)) * KP + (wid >> 2) * 32 + (lane & 3) * 8) * 2u;
  const unsigned kdst = lds0 + LDS_K + wid * 1024, vdst = lds0 + LDS_V + wid * 1024;
  #define DMA_K(t, slot) glds16(Kh + (long)(t) * KVBLK * KP, koff, (unsigned)__builtin_amdgcn_readfirstlane(kdst + (slot)))
  #define DMA_V(t, slot) glds16(Vh + (long)(t) * KVBLK * KP, voff, (unsigned)__builtin_amdgcn_readfirstlane(vdst + (slot)))
  const int vb0 = (int)(lds0 + LDS_V) + ((lane >> 4) & 1) * 32 + (lane & 3) * 8 + (4 * hi + ((lane & 15) >> 2)) * 64;
  bf16x8 kf[8];
  const lds_cptr kp0 = shm3 + LDS_K + hi * 1024 + r32 * 16; const lds_cptr vp0 = shm3 + LDS_V + ((lane >> 4) & 1) * 32 + (lane & 3) * 8 + (4 * hi + ((lane & 15) >> 2)) * 64;
  const __attribute__((address_space(3))) f32x4* bup = (const __attribute__((address_space(3))) f32x4*)(shm3 + LDS_BU) + hi;
  if (!has_prev) {
    DMA_K(0, 0); DMA_V(0, 0); DMA_K(1, SLOTB);
    const bf16* Qw = Q + (rowbase + q0 + rw) * DM + hw * D;
    #pragma unroll
    for (int d0 = 0; d0 < 4; ++d0) qr[d0] = *reinterpret_cast<const bf16x8*>(&Qw[(long)r32 * DM + d0 * 16 + hi * 8]);
    if (MODE == 0) {
      const float* ck = ckb + (size_t)(u.b * 16 + u.hq) * SEQ;
      const int nk = q0 + QROWS; const float cref = __hip_atomic_load((float*)ck + (nk - 1), __ATOMIC_RELAXED, __HIP_MEMORY_SCOPE_AGENT);
      const int k0 = tid * 4;
      if (k0 < nk) { const f32x4 c = *(const f32x4*)(ck + k0); *(f32x4*)((float*)(shm + LDS_BU) + k0) = (f32x4){cref, cref, cref, cref} - c; }
    }
    DMA_K(2, 2 * SLOTB);
  }
  float l_reg = 0.f; f32x16 o[2]; o[0] = f32x16{}; o[1] = f32x16{};
  const int dq = rw + r32 - (T0 * KVBLK - q0) - 4 * hi;
  #define CMASK(P0, P1, t) do { if (MODE == 1 || (t) >= NT - 4) amask<MODE>(P0, P1, dq - 64 * (t)); } while (0)
  #define MFMA32(a, b, c) __builtin_amdgcn_mfma_f32_32x32x16_bf16(a, b, c, 0, 0, 0)
  #define CI(X) (MODE ? f32x16{} : (X))
  #define BLD(P, base, j0) do { if (MODE == 0) { const f32x4 u_ = bup[(base) + 2 * (j0)], v_ = bup[(base) + 2 * (j0) + 2]; \
      P[4 * (j0)] = u_[0]; P[4 * (j0) + 1] = u_[1]; P[4 * (j0) + 2] = u_[2]; P[4 * (j0) + 3] = u_[3]; P[4 * (j0) + 4] = v_[0]; P[4 * (j0) + 5] = v_[1]; P[4 * (j0) + 6] = v_[2]; P[4 * (j0) + 7] = v_[3]; } } while (0)
  f32x16 pA0, pA1, pB0, pB1;
  int sl_prev = 0, sl_cur = 0, sl_next = SLOTB;
  #define ROT() do { sl_prev = sl_cur; sl_cur = sl_next; sl_next = (sl_next == (NSLOT - 1) * SLOTB) ? 0 : sl_next + SLOTB; } while (0)
  WAIT_BAR(3);
  if (MODE == 0) { BLD(pA0, 0, 0); BLD(pA0, 0, 2); BLD(pA1, 8, 0); BLD(pA1, 8, 2); }
  { const char* kb = shm + LDS_K + hi * 1024 + r32 * 16;
    #pragma unroll
    for (int d0 = 0; d0 < 4; ++d0) {
      const bf16x8 b0 = *reinterpret_cast<const bf16x8*>(kb + d0 * 2048);
      const bf16x8 b1 = *reinterpret_cast<const bf16x8*>(kb + d0 * 2048 + 512);
      if (d0 == 0) { pA0 = MFMA32(b0, qr[0], CI(pA0)); pA1 = MFMA32(b1, qr[0], CI(pA1)); }
      else { pA0 = MFMA32(b0, qr[d0], pA0); pA1 = MFMA32(b1, qr[d0], pA1); } } }
  CMASK(pA0, pA1, 0);
  _Pragma("unroll") for (int r = 0; r < 16; ++r) { pA0[r] = __builtin_amdgcn_exp2f(pA0[r]); pA1[r] = __builtin_amdgcn_exp2f(pA1[r]); }
  WAIT_BAR(0);
  DMA_K(3, 0); DMA_V(1, SLOTB);
  ROT();
  kload8(kf, kp0 + sl_cur);
  if (MODE == 0) { BLD(pB0, 16, 0); BLD(pB0, 16, 2); BLD(pB1, 24, 0); BLD(pB1, 24, 2); }
  WAIT_BAR(2);
  s16x4 vlo[8], vhi[8]; u32x4 pw0, pw1, pw2, pw3;
  #define PKW(P, B) cvtpk_s(P[B], P[B + 1])
  #define PAF(k) __builtin_bit_cast(bf16x8, pw##k)
  #define VFR(i) (bf16x8){vlo[i][0], vlo[i][1], vlo[i][2], vlo[i][3], vhi[i][0], vhi[i][1], vhi[i][2], vhi[i][3]}
  #define PIN(x) asm volatile("" : "+v"(x))
  #define GAPA(MF, A0, A1, A2, A3, W0, W1, PW) do { MF; sacc += A0; sacc += A1; sacc += A2; sacc += A3; PIN(sacc); W0; W1; PIN(PW); SBAR(); } while (0)
  #define EX(v) __builtin_amdgcn_exp2f(v)
  #define GAPB(MF, X, B) do { MF; X[B] = EX(X[B]); X[B + 1] = EX(X[B + 1]); X[B + 2] = EX(X[B + 2]); X[B + 3] = EX(X[B + 3]); PIN(X); SBAR(); } while (0)
  #define VRD(i) do { vlo[i] = vtr(vp_ + (((i) >> 2) * 4096 + ((i) & 3) * 1024)); vhi[i] = vtr(vp_ + (((i) >> 2) * 4096 + ((i) & 3) * 1024 + 512)); } while (0)
  #define KRD(G_, j) do { if (G_) { kload2(kf, kp0 + sl_next, j); SBAR(); } } while (0)
  #define BRD(G_, P, base, j0) do { if ((G_) && MODE == 0) { BLD(P, base, j0); SBAR(); } } while (0)
  #define STEP(C0, C1, P0, P1, t, GK, GV, GL) do { SBAR(); \
    const lds_cptr vp_ = vp0 + sl_prev; const int bb_ = 16 * ((t) + 1); \
    VRD(0); SBAR(); float sacc = (P0[0] + P0[1]); \
    GAPA(C0 = MFMA32(kf[0], qr[0], CI(C0)), P0[2], P0[3], P0[4], P0[5],     pw0[0] = PKW(P0, 0), pw0[1] = PKW(P0, 2), pw0); \
    VRD(4); SBAR(); GAPA(C1 = MFMA32(kf[1], qr[0], CI(C1)), P0[6], P0[7], P0[8], P0[9],     pw0[2] = PKW(P0, 4), pw0[3] = PKW(P0, 6), pw0); \
    VRD(1); SBAR(); GAPA(C0 = MFMA32(kf[2], qr[1], C0),   P0[10], P0[11], P0[12], P0[13], pw1[0] = PKW(P0, 8), pw1[1] = PKW(P0, 10), pw1); \
    VRD(5); SBAR(); GAPA(C1 = MFMA32(kf[3], qr[1], C1),   P0[14], P0[15], P1[0], P1[1],   pw1[2] = PKW(P0, 12), pw1[3] = PKW(P0, 14), pw1); \
    VRD(2); SBAR(); GAPA(C0 = MFMA32(kf[4], qr[2], C0),   P1[2], P1[3], P1[4], P1[5],     pw2[0] = PKW(P1, 0), pw2[1] = PKW(P1, 2), pw2); \
    VRD(6); SBAR(); GAPA(C1 = MFMA32(kf[5], qr[2], C1),   P1[6], P1[7], P1[8], P1[9],     pw2[2] = PKW(P1, 4), pw2[3] = PKW(P1, 6), pw2); \
    VRD(3); SBAR(); GAPA(C0 = MFMA32(kf[6], qr[3], C0),   P1[10], P1[11], P1[12], P1[13], pw3[0] = PKW(P1, 8), pw3[1] = PKW(P1, 10), pw3); \
    VRD(7); SBAR(); GAPA(C1 = MFMA32(kf[7], qr[3], C1),   P1[14], P1[15], 0.f, 0.f,       pw3[2] = PKW(P1, 12), pw3[3] = PKW(P1, 14), pw3); \
    l_reg += sacc; \
    if (GK) { DMA_K((t) + 3, sl_cur); } if (GV) { DMA_V((t) + 1, sl_next); } \
    CMASK(C0, C1, t); \
    SBAR(); \
    BRD(GL, P0, bb_, 0); GAPB(o[0] = MFMA32(PAF(0), VFR(0), o[0]), C0, 0); \
    BRD(GL, P0, bb_, 2); GAPB(o[1] = MFMA32(PAF(0), VFR(4), o[1]), C0, 4); \
    KRD(GL, 0); GAPB(o[0] = MFMA32(PAF(1), VFR(1), o[0]), C0, 8); \
    KRD(GL, 1); GAPB(o[1] = MFMA32(PAF(1), VFR(5), o[1]), C0, 12); \
    KRD(GL, 2); GAPB(o[0] = MFMA32(PAF(2), VFR(2), o[0]), C1, 0); \
    KRD(GL, 3); GAPB(o[1] = MFMA32(PAF(2), VFR(6), o[1]), C1, 4); \
    BRD(GL, P1, bb_ + 8, 0); GAPB(o[0] = MFMA32(PAF(3), VFR(3), o[0]), C1, 8); \
    BRD(GL, P1, bb_ + 8, 2); GAPB(o[1] = MFMA32(PAF(3), VFR(7), o[1]), C1, 12); \
    } while (0)
  int t = 1;
  #undef CMASK
  #define CMASK(P0, P1, t) do {} while (0)
  for (; t + 5 < NT; t += 2) {
    STEP(pB0, pB1, pA0, pA1, t, true, true, true);     WAIT_BAR(2); ROT();
    STEP(pA0, pA1, pB0, pB1, t + 1, true, true, true); WAIT_BAR(2); ROT();
  }
  #undef CMASK
  #define CMASK(P0, P1, t) do { if (MODE == 1 || (t) >= NT - 4) amask<MODE>(P0, P1, dq - 64 * (t)); } while (0)
  #define ENDW(tt) do { if ((tt) + 3 < NT) { WAIT_BAR(2); } else if ((tt) + 2 < NT) { WAIT_BAR(1); } else { WAIT_BAR(0); } } while (0)
  for (; t + 1 < NT; t += 2) {
    STEP(pB0, pB1, pA0, pA1, t, (t + 3 < NT), (t + 1 < NT), (t + 1 < NT));         ENDW(t);     ROT();
    STEP(pA0, pA1, pB0, pB1, t + 1, (t + 4 < NT), (t + 2 < NT), (t + 2 < NT));     ENDW(t + 1); ROT();
  }
  STEP(pB0, pB1, pA0, pA1, NT - 1, false, false, false);
  u32x4 gv[4];
  { const bf16* Gw0 = G + (rowbase + q0 + rw) * DM + hw * D;
    #pragma unroll
    for (int i = 0; i < 4; ++i) gv[i] = *(const u32x4*)(Gw0 + (long)(i * 8 + (lane >> 3)) * DM + (lane & 7) * 8); }
  f32x4 cn = {}; float crefn = 0.f; const int k0n = tid * 4, nkn = un.q0 + QROWS;
  if (has_next) {
    const int hwn = MODE ? un.hq + (wid >> 2) : un.hq;
    const bf16* Qn = Q + ((long)un.b * SEQ + un.q0 + rw) * DM + hwn * D;
    #pragma unroll
    for (int d0 = 0; d0 < 4; ++d0) qr[d0] = *reinterpret_cast<const bf16x8*>(&Qn[(long)r32 * DM + d0 * 16 + hi * 8]);
    if (MODE == 0) { const float* ckn = ckb + (size_t)(un.b * 16 + un.hq) * SEQ; crefn = __hip_atomic_load((float*)ckn + (nkn - 1), __ATOMIC_RELAXED, __HIP_MEMORY_SCOPE_AGENT); if (k0n < nkn) cn = *(const f32x4*)(ckn + k0n); }
  }
  { float sacc = pB0[0] + pB0[1]; _Pragma("unroll") for (int r = 2; r < 16; ++r) sacc += pB0[r]; _Pragma("unroll") for (int r = 0; r < 16; ++r) sacc += pB1[r]; l_reg += sacc;
    pw0 = (u32x4){PKW(pB0, 0), PKW(pB0, 2), PKW(pB0, 4), PKW(pB0, 6)}; pw1 = (u32x4){PKW(pB0, 8), PKW(pB0, 10), PKW(pB0, 12), PKW(pB0, 14)}; pw2 = (u32x4){PKW(pB1, 0), PKW(pB1, 2), PKW(pB1, 4), PKW(pB1, 6)}; pw3 = (u32x4){PKW(pB1, 8), PKW(pB1, 10), PKW(pB1, 12), PKW(pB1, 14)};
    SBAR(); pv(o, vb0 + sl_cur, PAF(0), PAF(1), PAF(2), PAF(3)); }
  asm volatile("s_waitcnt lgkmcnt(0)\n\ts_barrier" ::: "memory");
  if (has_next) {
    if (MODE == 0) { if (k0n < nkn) *(f32x4*)((float*)(shm + LDS_BU) + k0n) = (f32x4){crefn, crefn, crefn, crefn} - cn; }
    const bf16* Khn = K + ((long)un.b * SEQ + (long)un.T0 * KVBLK) * KP + un.kvh * D, *Vhn = V + ((long)un.b * SEQ + (long)un.T0 * KVBLK) * KP + un.kvh * D;
    glds16(Khn, koff, (unsigned)__builtin_amdgcn_readfirstlane(kdst)); glds16(Vhn, voff, (unsigned)__builtin_amdgcn_readfirstlane(vdst));
    glds16(Khn + (long)KVBLK * KP, koff, (unsigned)__builtin_amdgcn_readfirstlane(kdst + SLOTB)); glds16(Khn + 2L * KVBLK * KP, koff, (unsigned)__builtin_amdgcn_readfirstlane(kdst + 2 * SLOTB));
  }
  #undef PKW
  #undef PAF
  #undef VFR
  #undef PIN
  #undef GAPA
  #undef GAPB
  #undef EX
  #undef VRD
  #undef KRD
  #undef BRD
  #undef STEP
  #undef ENDW
  { auto rr = __builtin_amdgcn_permlane32_swap(__float_as_uint(l_reg), __float_as_uint(l_reg), false, false); l_reg = __uint_as_float(rr[0]) + __uint_as_float(rr[1]); }
  if (MODE == 1) l_reg += __builtin_amdgcn_exp2f(sinks[hw] * 1.4426950408889634f);
  int lane_e = lane; asm volatile("" : "+v"(lane_e));
  const int r32e = lane_e & 31, hie = lane_e >> 5;
  float* wsfe = (float*)(shm + LDS_WS) + wid * 64;
  if (hie == 0) wsfe[32 + r32e] = l_reg; asm volatile("s_waitcnt lgkmcnt(0)" ::: "memory");
  float rli[16];
  #pragma unroll
  for (int r = 0; r < 16; ++r) rli[r] = __builtin_amdgcn_rcpf(wsfe[32 + crow(r, hie)]);
  bf16* Ow = O + (rowbase + q0 + rw) * DM + hw * D;
  { float* stg = (float*)(shm + LDS_OST) + wid * 2048;
    #pragma unroll
    for (int r = 0; r < 16; ++r) { const int orow = crow(r, hie);
      #pragma unroll
      for (int d0 = 0; d0 < 2; ++d0) stg[orow * 64 + d0 * 32 + r32e] = o[d0][r] * rli[r]; }
    asm volatile("s_waitcnt lgkmcnt(0)" ::: "memory");
    #pragma unroll
    for (int i = 0; i < 4; ++i) { const int row = i * 8 + (lane_e >> 3), ch = lane_e & 7;
      const f32x4 a0 = *(const f32x4*)(stg + row * 64 + ch * 8), a1 = *(const f32x4*)(stg + row * 64 + ch * 8 + 4);
      u32x4 w;
      w.x = cvtpk_s(a0[0] * __uint_as_float(gv[i].x << 16), a0[1] * __uint_as_float(gv[i].x & 0xffff0000u));
      w.y = cvtpk_s(a0[2] * __uint_as_float(gv[i].y << 16), a0[3] * __uint_as_float(gv[i].y & 0xffff0000u));
      w.z = cvtpk_s(a1[0] * __uint_as_float(gv[i].z << 16), a1[1] * __uint_as_float(gv[i].z & 0xffff0000u));
      w.w = cvtpk_s(a1[2] * __uint_as_float(gv[i].w << 16), a1[3] * __uint_as_float(gv[i].w & 0xffff0000u));
      *(u32x4*)(Ow + (long)row * DM + ch * 8) = w; } }
  #undef DMA_K
  #undef DMA_V
  #undef CMASK
  #undef MFMA32
  #undef CI
  #undef BLD
  #undef ROT
}
constexpr int ATTN_LDS_BYTES = LDS_BYTES;
#undef SBAR
#undef WAIT_BAR
}

constexpr int NWAVES = 8;
constexpr size_t WS_DUMMY = 184 * MiB;
constexpr int N_PHASES = 7;
constexpr size_t CTL_ZERO_BYTES = 1 * MiB;
constexpr int CW_BAR = 4096;
constexpr int RING_OFF = 0, RING_BYTES = 131072;
constexpr int LDSCTL_OFF = RING_BYTES, MISC_OFF = LDSCTL_OFF + 320;
constexpr int XCH_OFF = RING_BYTES + 1024;
constexpr int LDS_BYTES = 147456;
static_assert(XCH_OFF + 8192 <= LDS_BYTES && MISC_OFF + 128 <= XCH_OFF, "LDS map");

#define GAS __attribute__((address_space(1)))
#define LAS __attribute__((address_space(3)))
typedef unsigned v4u __attribute__((ext_vector_type(4)));
typedef GAS unsigned gu32;
#define RLX_AGENT __ATOMIC_RELAXED, __HIP_MEMORY_SCOPE_AGENT
#define LDS_WAIT() asm volatile("s_waitcnt lgkmcnt(0)" ::: "memory")
#define VM_WAIT() asm volatile("s_waitcnt vmcnt(0)" ::: "memory")
__device__ __forceinline__ unsigned pk2(float lo, float hi) { return f2bf(lo) | (f2bf(hi) << 16); }

#define XB_TMO      128
#define XB_XCNT(j)  (256  + 64 * (j))
#define XB_XSUB(j)  (1280 + 64 * (j))
#define XB_XGEN(j)  (2304 + 64 * (j))
#define XB_TOP      3328
#define XB_TOPGEN   3392
#define XCD_BAR_WORDS 3456
#define XB_SPIN_CAP (1u << 18)

__device__ __forceinline__ unsigned xb_ld(unsigned* p)              { return __hip_atomic_load(p, __ATOMIC_RELAXED, __HIP_MEMORY_SCOPE_AGENT); }
__device__ __forceinline__ unsigned xb_add(unsigned* p, unsigned v) { return __hip_atomic_fetch_add(p, v, __ATOMIC_RELAXED, __HIP_MEMORY_SCOPE_AGENT); }
__device__ __forceinline__ unsigned xb_xcc_id() { return (unsigned)__builtin_amdgcn_s_getreg((3 << 11) | 20) & 0xFu; }
#define XB_SPIN(cond, bar) do { unsigned _sp = 0; while (cond) { __builtin_amdgcn_s_sleep(1); \
    if ((++_sp & 255u) == 0u) { if (xb_ld(&(bar)[XB_TMO])) break; if (_sp > XB_SPIN_CAP) { atomicAdd(&(bar)[XB_TMO], 1u); break; } } } } while (0)

struct XcdBarrier {
    unsigned* bar; unsigned x;
    volatile LAS unsigned* st;
};

__device__ __forceinline__ XcdBarrier xcd_barrier_post(unsigned* bar, volatile LAS unsigned* st) {
    XcdBarrier b; b.bar = bar; b.x = xb_xcc_id(); b.st = st;
    if (threadIdx.x == 0) (void)xb_add(&bar[XB_XCNT(b.x)], 1u);
    return b;
}
__device__ __forceinline__ void xcd_barrier_complete(unsigned* bar, unsigned x, unsigned& nloc, unsigned& nx) {
    const unsigned G = gridDim.x * gridDim.y * gridDim.z;
    unsigned sum, cnt, mine, sp = 0u;
    for (;;) {
        sum = 0u; cnt = 0u; mine = 0u;
#pragma unroll
        for (unsigned j = 0; j < 16; ++j) { const unsigned c = xb_ld(&bar[XB_XCNT(j)]); sum += c; cnt += (c > 0u) ? 1u : 0u; mine = (j == x) ? c : mine; }
        if (sum == G) break;
        __builtin_amdgcn_s_sleep(1);
        if ((++sp & 255u) == 0u) { if (xb_ld(&bar[XB_TMO])) break; if (sp > XB_SPIN_CAP) { atomicAdd(&bar[XB_TMO], 1u); break; } }
    }
    nloc = mine > 0u ? mine : 1u; nx = cnt > 0u ? cnt : 1u;
}

__device__ __forceinline__ void xcd_barrier(const XcdBarrier& b) {
    asm volatile("s_waitcnt vmcnt(0)" ::: "memory");
    __syncthreads();
    if (threadIdx.x == 0) {
        unsigned* bar = b.bar;
        __builtin_amdgcn_s_waitcnt(0);
        unsigned nloc = b.st[0], nx = b.st[1];
        if (nloc == 0u) { xcd_barrier_complete(bar, b.x, nloc, nx); b.st[0] = nloc; b.st[1] = nx; }
        const unsigned old = xb_add(&bar[XB_XSUB(b.x)], 1u);
        const unsigned gen = old / nloc;
        if (old + 1u == (gen + 1u) * nloc) {
            __builtin_amdgcn_fence(__ATOMIC_RELEASE, "agent");
            asm volatile("s_waitcnt vmcnt(0)" ::: "memory");
            const unsigned og = xb_add(&bar[XB_TOP], 1u);
            const unsigned tg = og / nx;
            if (og + 1u == (tg + 1u) * nx) xb_add(&bar[XB_TOPGEN], 1u);
            else XB_SPIN(xb_ld(&bar[XB_TOPGEN]) == tg, bar);
            __builtin_amdgcn_fence(__ATOMIC_ACQUIRE, "agent");
            xb_add(&bar[XB_XGEN(b.x)], 1u);
            asm volatile("s_waitcnt vmcnt(0)" ::: "memory");
        } else {
            XB_SPIN(xb_ld(&bar[XB_XGEN(b.x)]) == gen, bar);
            __builtin_amdgcn_fence(__ATOMIC_ACQUIRE, "agent");
            asm volatile("s_waitcnt vmcnt(0)" ::: "memory");
        }
    }
    __syncthreads();
}

template <int NLATE> __device__ __forceinline__ void xcd_barrier_late(const XcdBarrier& b) {
    asm volatile("s_waitcnt vmcnt(%0)" :: "n"(NLATE) : "memory");
    asm volatile("s_waitcnt lgkmcnt(0)" ::: "memory"); __builtin_amdgcn_s_barrier(); asm volatile("" ::: "memory");
    if (threadIdx.x == 0) {
        unsigned* bar = b.bar;
        unsigned nloc = b.st[0], nx = b.st[1];
        if (nloc == 0u) { xcd_barrier_complete(bar, b.x, nloc, nx); b.st[0] = nloc; b.st[1] = nx; }
        const unsigned old = xb_add(&bar[XB_XSUB(b.x)], 1u);
        const unsigned gen = old / nloc;
        if (old + 1u == (gen + 1u) * nloc) {
            __builtin_amdgcn_fence(__ATOMIC_RELEASE, "agent");
            asm volatile("s_waitcnt vmcnt(0)" ::: "memory");
            const unsigned og = xb_add(&bar[XB_TOP], 1u);
            const unsigned tg = og / nx;
            if (og + 1u == (tg + 1u) * nx) xb_add(&bar[XB_TOPGEN], 1u);
            else XB_SPIN(xb_ld(&bar[XB_TOPGEN]) == tg, bar);
            __builtin_amdgcn_fence(__ATOMIC_ACQUIRE, "agent");
            xb_add(&bar[XB_XGEN(b.x)], 1u);
            asm volatile("s_waitcnt vmcnt(0)" ::: "memory");
        } else {
            XB_SPIN(xb_ld(&bar[XB_XGEN(b.x)]) == gen, bar);
            __builtin_amdgcn_fence(__ATOMIC_ACQUIRE, "agent");
            asm volatile("s_waitcnt vmcnt(0)" ::: "memory");
        }
    }
    asm volatile("s_waitcnt lgkmcnt(0)" ::: "memory"); __builtin_amdgcn_s_barrier(); asm volatile("" ::: "memory");
}

struct Frame {
    LAS unsigned char* lds;
    volatile LAS unsigned* MISC;
    gu32* ctl;
    int tid, lane, wave;
    int vcu, G;
};

__device__ __forceinline__ void p0_transpose_item(const float* W, int ldw, int col0, const float* gain, bf16_t* WT, LAS float* scr, int k0, int lane) {
    float w[32];
#pragma unroll
    for (int i = 0; i < 32; ++i) w[i] = W[(size_t)(k0 + 2 * i + (lane >> 5)) * ldw + col0 + (lane & 31)];
    const int c = lane & 7;
    f32x4 g0 = {1.f, 1.f, 1.f, 1.f}, g1 = g0;
    if (gain) { g0 = *(const f32x4*)(gain + k0 + 8 * c); g1 = *(const f32x4*)(gain + k0 + 8 * c + 4); }
#pragma unroll
    for (int i = 0; i < 32; ++i) { const int kk = 2 * i + (lane >> 5); scr[kk * 32 + ((lane & 31) ^ (((kk >> 3) & 7) << 2))] = w[i]; }
    LDS_WAIT(); asm volatile("" ::: "memory");
#pragma unroll
    for (int j = 0; j < 4; ++j) { const int n = (lane >> 3) + 8 * j; const LAS float* s = scr + (8 * c) * 32 + (n ^ (c << 2));
        v4u o; o.x = pk2(s[0 * 32] * g0[0], s[1 * 32] * g0[1]); o.y = pk2(s[2 * 32] * g0[2], s[3 * 32] * g0[3]); o.z = pk2(s[4 * 32] * g1[0], s[5 * 32] * g1[1]); o.w = pk2(s[6 * 32] * g1[2], s[7 * 32] * g1[3]);
        *(GAS v4u*)(WT + (size_t)n * 1024 + k0 + 8 * c) = o; }
    LDS_WAIT(); asm volatile("" ::: "memory");
}
__device__ __forceinline__ void p0_rows4(Frame& F, const P& p, int m0, const LAS float* WFl) {
    bf16_t* XB = (bf16_t*)(p.ws + WS_XB); float* RS0 = (float*)(p.ws + WS_RS0); float* LF = (float*)(p.ws + WS_LF);
    const int lane = F.lane;
    f32x4 v[4][4]; float rstd[4];
#pragma unroll
    for (int r = 0; r < 4; ++r) { const f32x4* xr = (const f32x4*)(p.x + (size_t)(m0 + r) * 1024) + lane; float ss = 0.f;
#pragma unroll
        for (int j = 0; j < 4; ++j) { v[r][j] = xr[64 * j]; ss += (v[r][j][0] * v[r][j][0] + v[r][j][1] * v[r][j][1]) + (v[r][j][2] * v[r][j][2] + v[r][j][3] * v[r][j][3]); }
        ss = wave_sum(ss); rstd[r] = 1.0f / sqrtf(ss * (1.0f / 1024.0f) + EPS); }
#pragma unroll
    for (int r = 0; r < 4; ++r)
#pragma unroll
        for (int j = 0; j < 4; ++j) { uint2 o; o.x = pk2(v[r][j][0], v[r][j][1]); o.y = pk2(v[r][j][2], v[r][j][3]); *(uint2*)(XB + (size_t)(m0 + r) * 1024 + 4 * (lane + 64 * j)) = o; }
    float a[64];
#pragma unroll
    for (int i = 0; i < 64; ++i) a[i] = 0.f;
#pragma unroll
    for (int h = 0; h < 16; ++h)
#pragma unroll
        for (int j = 0; j < 4; ++j) { const f32x4 w = *(const LAS f32x4*)(WFl + h * 1024 + 4 * (lane + 64 * j));
#pragma unroll
            for (int r = 0; r < 4; ++r) a[r * 16 + h] += (v[r][j][0] * w[0] + v[r][j][1] * w[1]) + (v[r][j][2] * w[2] + v[r][j][3] * w[3]);
            if (j == 3) asm volatile("" ::: "memory"); }
#define TR_STEP(OFF) { const bool up = (lane & OFF) != 0; _Pragma("unroll") for (int i = 0; i < OFF; ++i) { const float keep = up ? a[i + OFF] : a[i]; const float send = up ? a[i] : a[i + OFF]; a[i] = keep + __shfl_xor(send, OFF); } }
    TR_STEP(32) TR_STEP(16) TR_STEP(8) TR_STEP(4) TR_STEP(2) TR_STEP(1)
#undef TR_STEP
    const int rsel = lane >> 4, h = lane & 15;
    const float rsd = rsel == 0 ? rstd[0] : rsel == 1 ? rstd[1] : rsel == 2 ? rstd[2] : rstd[3];
    const float z = a[0] * rsd + p.b_forget[h];
    const float lf = fminf(z, 0.f) - log1pf(expf(-fabsf(z)));
    const int row = m0 + rsel, b = row / SEQ, s = row % SEQ;
    LF[((size_t)b * 16 + h) * SEQ + s] = lf;
    if (lane < 4) RS0[m0 + lane] = lane == 0 ? rstd[0] : lane == 1 ? rstd[1] : lane == 2 ? rstd[2] : rstd[3];
}
__device__ __forceinline__ void p0_prologue(Frame& F, const P& p) {
    bf16_t* WTA = (bf16_t*)(p.ws + WS_WTA); bf16_t* WTOA = (bf16_t*)(p.ws + WS_WTOA); bf16_t* WTB = (bf16_t*)(p.ws + WS_WTB); bf16_t* WTOB = (bf16_t*)(p.ws + WS_WTOB);
    LAS float* scr = (LAS float*)(F.lds + RING_OFF + F.wave * 8192);
    LAS float* WFl = (LAS float*)(F.lds + RING_OFF + 65536);
    const int gw = F.vcu * NWAVES + F.wave, NGW = F.G * NWAVES;
    { float wv[32], gv[32];
#pragma unroll
      for (int i = 0; i < 32; ++i) { const int e = F.tid + i * (NWAVES * 64), k = e >> 4, h = e & 15; wv[i] = p.w_in_a[(size_t)k * WINA + 3072 + h]; gv[i] = p.norm_a_g[k]; }
#pragma unroll
      for (int i = 0; i < 32; ++i) { const int e = F.tid + i * (NWAVES * 64), k = e >> 4, h = e & 15; WFl[h * 1024 + k] = gv[i] * wv[i]; } }
    __syncthreads();
    for (int rg = gw; rg < M / 4; rg += NGW) p0_rows4(F, p, rg * 4, WFl);
    constexpr int I_A = 16 * 128, I_OA = 16 * 32, I_KV = 16 * 16, I_B = 16 * 64, I_OB = 16 * 32, NITEMS = I_A + I_OA + I_KV + I_B + I_OB;
    for (int it = gw; it < NITEMS; it += NGW) {
        int r = it;
        if (r < I_A) { const int kb = r / 128, n0 = 32 * (r % 128); p0_transpose_item(p.w_in_a, WINA, n0 + (n0 >= 3072 ? 16 : 0), p.norm_a_g, WTA + (size_t)n0 * 1024, scr, 64 * kb, F.lane); continue; } r -= I_A;
        if (r < I_OA) { const int kb = r / 32, n0 = 32 * (r % 32); p0_transpose_item(p.w_out_a, 1024, n0, nullptr, WTOA + (size_t)n0 * 1024, scr, 64 * kb, F.lane); continue; } r -= I_OA;
        if (r < I_KV) { const int kb = r / 16, n0 = 32 * (r % 16); p0_transpose_item(p.w_kv, 512, n0, p.kv_norm_g, WTB + (size_t)n0 * 1024, scr, 64 * kb, F.lane); continue; } r -= I_KV;
        if (r < I_B) { const int kb = r / 64, n0 = 32 * (r % 64); p0_transpose_item(p.w_in_b, 2048, n0, p.norm_b_g, WTB + (size_t)(512 + n0) * 1024, scr, 64 * kb, F.lane); continue; } r -= I_B;
        { const int kb = r / 32, n0 = 32 * (r % 32); p0_transpose_item(p.w_out_b, 1024, n0, nullptr, WTOB + (size_t)n0 * 1024, scr, 64 * kb, F.lane); }
    }
    { const int gt = (F.G - 1 - F.vcu) * (NWAVES * 64) + F.tid;
      if (gt < 2048 * 8) { float* ROPE = (float*)(p.ws + WS_ROPE); const int s = gt >> 3, f = gt & 7; double sn, cs; sincos_d((double)p.positions[s] * p.invf[f], sn, cs); ROPE[gt] = (float)cs; ROPE[2048 * 8 + gt] = (float)sn; } }
    __syncthreads();
}
__device__ __forceinline__ void p1_scan(Frame& F, const P& p) {
    LAS double* wsum = (LAS double*)(F.lds + RING_OFF);
    const float* LF = (const float*)(p.ws + WS_LF); float* CK2 = (float*)(p.ws + WS_CK2);
    for (int job = (int)blockIdx.x; job < 2 * BATCH * NH; job += F.G) {
        const int bh = job >> 1, half = job & 1;
        const f32x4 v = *(const f32x4*)(LF + (size_t)bh * SEQ + F.tid * 4);
        const double l0 = (double)v[0], l1 = l0 + (double)v[1], l2 = l1 + (double)v[2], l3 = l2 + (double)v[3]; double incl = l3;
#pragma unroll
        for (int o = 1; o < 64; o <<= 1) { const double t = __shfl_up(incl, o); if (F.lane >= o) incl += t; }
        if (F.lane == 63) wsum[F.wave] = incl;
        __syncthreads();
        double base = 0.0;
#pragma unroll
        for (int w = 0; w < NWAVES; ++w) { const double t = wsum[w]; if (w < F.wave) base += t; }
        const double excl = base + incl - l3, L2E = 1.4426950408889634;
        if ((F.tid >> 8) == half) *(f32x4*)(CK2 + (size_t)bh * SEQ + F.tid * 4) = (f32x4){(float)((excl + l0) * L2E), (float)((excl + l1) * L2E), (float)((excl + l2) * L2E), (float)((excl + l3) * L2E)};
        __syncthreads();
    }
}
template <int MODE> __device__ __forceinline__ attn_body::AUnit attn_unit_of(int pv, int i) {
    attn_body::AUnit u;
    if (MODE == 0) { const int bh = pv >> 1, s = pv & 1, qb = (i == 0) ? s : (i == 1) ? 3 - s : (i == 2) ? 4 + s : 7 - s;
        u.b = bh >> 4; u.kvh = bh & 15; u.hq = bh & 15; u.q0 = 256 * qb; u.T0 = 0; }
    else { const int j = pv & 7, kvh = (pv >> 3) & 3, b = pv >> 5, qb = 2 * j + (i >> 1), hp = i & 1;
        u.b = b; u.kvh = kvh; u.hq = kvh * 4 + hp * 2; u.q0 = 128 * qb; u.T0 = qb > 0 ? 2 * qb - 2 : 0; }
    return u;
}
template <int MODE> __device__ __forceinline__ void attn_phase(Frame& F, const P& p, char* lds, bool dry) {
    typedef attn_body::bf16 abf;
    abf* Q = (abf*)(p.ws + (MODE ? WS_K0 : WS_Q0)); const abf* K = (const abf*)(p.ws + (MODE ? WS_G0 : WS_K0)); const abf* V = (const abf*)(p.ws + (MODE ? WS_G0 + 8 * MiB : WS_V0)); const abf* G = (const abf*)(p.ws + (MODE ? WS_V0 : WS_G0));
    abf* O = dry ? (abf*)(p.ws + WS_DUMMY) : Q;
    const float* ckb = (const float*)(p.ws + WS_CK2);
    attn_body::bf16x8 qr[4];
    const int n_units = F.vcu < 256 ? 4 * ((255 - F.vcu) / F.G + 1) : 0;
#pragma unroll 1
    for (int k = 0; k < n_units; ++k) {
        const int pv = F.vcu + (k >> 2) * F.G, pvn = F.vcu + ((k + 1) >> 2) * F.G;
        const attn_body::AUnit u = attn_unit_of<MODE>(pv, k & 3), un = attn_unit_of<MODE>(pvn, (k + 1) & 3);
        attn_body::attn_unit<MODE>(u, un, k > 0, k + 1 < n_units, qr, Q, K, V, G, O, ckb, p.sinks, lds);
    }
}

#ifndef PROBE_PHASE
#define PROBE_PHASE (-1)
#endif
#ifndef PROBE_REPS
#define PROBE_REPS 0
#endif
#define REPLOOP(k) for (int rep_ = (PROBE_PHASE == (k)) ? -(PROBE_REPS) : 0; rep_ <= 0; ++rep_)
#define DRY (rep_ < 0)
#define REPSEAM(k) do { if (DRY) xcd_barrier(bar); else SEAM(k); } while (0)
struct Args { P p; int ph_lo, ph_hi, li, pad; };
__global__ void __launch_bounds__(NWAVES * 64, 2) mk_fwd(Args args) {
    extern __shared__ __attribute__((aligned(16))) unsigned char lds[];
    const P& p = args.p;
    Frame F;
    F.lds = (LAS unsigned char*)lds;
    F.MISC = (volatile LAS unsigned*)(F.lds + MISC_OFF);
    F.tid = threadIdx.x; F.lane = F.tid & 63; F.wave = __builtin_amdgcn_readfirstlane(F.tid >> 6);
    F.G = gridDim.x; { const int bx = blockIdx.x; F.vcu = (F.G % 8 == 0) ? (bx % 8) * (F.G / 8) + bx / 8 : bx; }
    F.ctl = (gu32*)(p.ws + WS_CTL);
    for (int u = F.tid; u < (XCH_OFF - LDSCTL_OFF) / 4; u += NWAVES * 64) ((LAS unsigned*)(F.lds + LDSCTL_OFF))[u] = 0u;
    __syncthreads();
    const int lo = args.ph_lo, hi = args.ph_hi;
    XcdBarrier bar; bar.bar = (unsigned*)(F.ctl + CW_BAR) + args.li * XCD_BAR_WORDS; bar.x = 0; bar.st = nullptr;
    if (hi - lo > 1 || PROBE_REPS > 0) bar = xcd_barrier_post((unsigned*)(F.ctl + CW_BAR) + args.li * XCD_BAR_WORDS, F.MISC + 8);
#ifndef PHASE_MASK
#define PHASE_MASK 127
#endif
#define IN(k) (((PHASE_MASK >> (k)) & 1) && lo <= (k) && (k) < hi)
#define SEAM(k) do { if (IN(k) && IN((k) + 1)) xcd_barrier(bar); } while (0)
    PG8_LAS float* xch = (PG8_LAS float*)(F.lds + XCH_OFF);

    if (IN(0)) REPLOOP(0) { p0_prologue(F, p); REPSEAM(0); }

    if (IN(1)) REPLOOP(1) {
        p1_scan(F, p);
        pg8::Gemm g{(const pg8::bf16_t*)(p.ws + WS_XB), (const pg8::bf16_t*)(p.ws + WS_WTA), M, NA, 1024}; pg8::StaticOrder S; S.init(M, NA, F.G, (int)blockIdx.x);
        pg8::EpiProj<0> E{(const float*)(p.ws + WS_RS0), p.qnorm_a_g, p.knorm_a_g, nullptr, (pg8::bf16_t*)(p.ws + WS_Q0), xch};
        pg8::gemm_phase<pg8::EpiProj<0>, pg8::StaticOrder, true, true>(F.lds + RING_OFF, g, S, E);
        REPSEAM(1);
    }
    if (IN(2)) { static_assert(attn_body::ATTN_LDS_BYTES <= RING_BYTES, "attention body geometry vs frame"); REPLOOP(2) { attn_phase<0>(F, p, (char*)lds + RING_OFF, DRY); REPSEAM(2); } }
    if (IN(3)) REPLOOP(3) {
        pg8::Gemm g{(const pg8::bf16_t*)(p.ws + WS_Q0), (const pg8::bf16_t*)(p.ws + WS_WTOA), M, 1024, 1024}; pg8::StaticOrder S; S.init(M, 1024, F.G, (int)blockIdx.x);
        pg8::EpiRes1 E{p.x, p.out, (pg8::bf16_t*)(p.ws + WS_XB), (float*)(p.ws + WS_SS1)};
        pg8::gemm_phase<pg8::EpiRes1, pg8::StaticOrder, false, true>(F.lds + RING_OFF, g, S, E);
        if (DRY) xcd_barrier(bar); else if (IN(3) && IN(4)) xcd_barrier_late<pg8::EpiRes1::LATE_STORES>(bar);
    }
    if (IN(4)) REPLOOP(4) {
        pg8::Gemm g{(const pg8::bf16_t*)(p.ws + WS_XB), (const pg8::bf16_t*)(p.ws + WS_WTB), M, NB, 1024}; pg8::StaticOrder S; S.init(M, NB, F.G, (int)blockIdx.x);
        pg8::EpiProj<1> E{(const float*)(p.ws + WS_SS1), p.qnorm_b_g, p.knorm_b_g, (const float*)(p.ws + WS_ROPE), (pg8::bf16_t*)(p.ws + WS_K0), xch};
        static_assert(WS_K0 - WS_Q0 == 32 * MiB && WS_V0 - WS_K0 == 32 * MiB && WS_G0 - WS_V0 == 32 * MiB, "EpiProj's output offsets");
        pg8::gemm_phase<pg8::EpiProj<1>, pg8::StaticOrder, true, true>(F.lds + RING_OFF, g, S, E);
        REPSEAM(4);
    }
    if (IN(5)) REPLOOP(5) { attn_phase<1>(F, p, (char*)lds + RING_OFF, DRY); REPSEAM(5); }
    if (IN(6)) REPLOOP(6) {
        pg8::Gemm g{(const pg8::bf16_t*)(p.ws + WS_K0), (const pg8::bf16_t*)(p.ws + WS_WTOB), M, 1024, 1024}; pg8::StaticOrder S; S.init(M, 1024, F.G, (int)blockIdx.x);
        pg8::EpiRes2 E{DRY ? (float*)(p.ws + WS_DUMMY) : p.out};
        pg8::gemm_phase<pg8::EpiRes2, pg8::StaticOrder, false, true>(F.lds + RING_OFF, g, S, E);
        if (DRY) xcd_barrier(bar);
    }
#undef IN
#undef SEAM
}

#ifndef MK_CUTS
#define MK_CUTS 0
#endif
#ifndef NAIVE_MASK
#define NAIVE_MASK 0
#endif
extern "C" void kernel_launch(void* const* d_in, const int* in_sizes, int n_in, void* d_out, int out_size, void* d_ws, size_t ws_size, hipStream_t stream) {
    static int grid = 0;
    if (grid == 0) {
        if (n_in != 16 || out_size != M * DM || ws_size < WS_DUMMY + 64 * MiB) { fprintf(stderr, "kernel_launch: unexpected shapes (n_in %d out %d ws %zu); nothing launched\n", n_in, out_size, ws_size); grid = -1; return; }
        int dev = 0, cus = 0, per_cu = 0;
        if (hipGetDevice(&dev) != hipSuccess || hipDeviceGetAttribute(&cus, hipDeviceAttributeMultiprocessorCount, dev) != hipSuccess) { fprintf(stderr, "kernel_launch: hipGetDevice / hipDeviceGetAttribute failed\n"); grid = -1; return; }
        if (hipFuncSetAttribute((const void*)mk_fwd, hipFuncAttributeMaxDynamicSharedMemorySize, LDS_BYTES) != hipSuccess) { fprintf(stderr, "kernel_launch: hipFuncSetAttribute failed\n"); grid = -1; return; }
        if (hipOccupancyMaxActiveBlocksPerMultiprocessor(&per_cu, (const void*)mk_fwd, NWAVES * 64, LDS_BYTES) != hipSuccess || per_cu < 1)
            fprintf(stderr, "kernel_launch: note: the occupancy query reports %d workgroups per CU\n", per_cu);
        (void)hipGetLastError();
        grid = cus;
        if (grid != 256) fprintf(stderr, "kernel_launch: %d CUs; this kernel is built for 256 (one 256x256 unit per workgroup in the out-projection phases)\n", grid);
    }
    if (grid < 0) return;
    if (hipMemsetAsync((char*)d_ws + WS_CTL, 0, CTL_ZERO_BYTES, stream) != hipSuccess) { fprintf(stderr, "kernel_launch: hipMemsetAsync of the control words failed\n"); return; }
    Args a{};
    P& p = a.p;
    p.x = (const float*)d_in[0]; p.positions = (const int*)d_in[1]; p.norm_a_g = (const float*)d_in[2]; p.w_in_a = (const float*)d_in[3]; p.b_forget = (const float*)d_in[4];
    p.qnorm_a_g = (const float*)d_in[5]; p.knorm_a_g = (const float*)d_in[6]; p.w_out_a = (const float*)d_in[7]; p.kv_norm_g = (const float*)d_in[8]; p.w_kv = (const float*)d_in[9];
    p.knorm_b_g = (const float*)d_in[10]; p.norm_b_g = (const float*)d_in[11]; p.w_in_b = (const float*)d_in[12]; p.qnorm_b_g = (const float*)d_in[13]; p.sinks = (const float*)d_in[14];
    p.w_out_b = (const float*)d_in[15]; p.out = (float*)d_out; p.ws = (unsigned char*)d_ws;
    for (int i = 0; i < 8; ++i) p.invf[i] = std::pow(500000.0, -(double)i / 8.0);
    int lo = 0, li = 0;
    for (int ph = 0; ph < N_PHASES; ++ph) {
        const bool naive = (NAIVE_MASK >> ph) & 1;
        if (naive) {
            switch (ph) {
                case 0: k_prep_weights<<<2048, 256, 0, stream>>>(p); k_prep_x<<<M / 4, 256, 0, stream>>>(p); break;
                case 1: k_scan<<<BATCH * NH, 256, 0, stream>>>(p); k_gemm_naive<0><<<dim3(NA / 64, M / 64), 256, 0, stream>>>(p); break;
                case 2: k_attn_naive<0><<<dim3(SEQ / 64, BATCH * NH), 256, 0, stream>>>(p); break;
                case 3: k_gemm_naive<1><<<dim3(1024 / 64, M / 64), 256, 0, stream>>>(p); k_rowstat<<<M / 4, 256, 0, stream>>>(p); break;
                case 4: k_gemm_naive<2><<<dim3(NB / 64, M / 64), 256, 0, stream>>>(p); break;
                case 5: k_attn_naive<1><<<dim3(SEQ / 64, BATCH * NH), 256, 0, stream>>>(p); break;
                default: k_gemm_naive<3><<<dim3(1024 / 64, M / 64), 256, 0, stream>>>(p); break;
            }
            lo = ph + 1; continue;
        }
        const bool cut_after = (ph == N_PHASES - 1) || ((MK_CUTS >> ph) & 1) || ((NAIVE_MASK >> (ph + 1)) & 1);
        if (cut_after) {
            a.ph_lo = lo; a.ph_hi = ph + 1; a.li = li++;
            hipLaunchKernelGGL(mk_fwd, dim3(grid), dim3(NWAVES * 64), LDS_BYTES, stream, a);
            const hipError_t le = hipPeekAtLastError();
            if (le != hipSuccess) { fprintf(stderr, "kernel_launch: launch of phases [%d,%d) failed: %s\n", lo, ph + 1, hipGetErrorName(le)); break; }
            lo = ph + 1;
        }
    }
}
```

```cpp
#define MK_CUTS 0
#define NAIVE_MASK 0
#include <hip/hip_runtime.h>
#include <stdint.h>
#include <cstdio>
#include <cmath>

typedef unsigned short bf16_t;
typedef short bf16x8 __attribute__((ext_vector_type(8)));
typedef float f32x4 __attribute__((ext_vector_type(4)));

constexpr int BATCH = 8, SEQ = 2048, DM = 1024, NH = 16, HD = 64, M = BATCH * SEQ;
constexpr int KVW = 256;
constexpr int NA = 4096;
constexpr int NB = 2560;
constexpr int WINA = 4112;
constexpr float EPS = 1e-6f;
constexpr float LOG2E = 1.4426950408889634f;
constexpr float C2 = 0.125f * LOG2E;

constexpr size_t MiB = 1u << 20;
constexpr size_t WS_CTL = 0;
constexpr size_t WS_WTA = 2 * MiB;
constexpr size_t WS_WTOA = 10 * MiB;
constexpr size_t WS_WTB = 12 * MiB;
constexpr size_t WS_WTOB = 17 * MiB;
constexpr size_t WS_WF = 19 * MiB;
constexpr size_t WS_ROPE = 19 * MiB + 65536;
constexpr size_t WS_RS0 = 20 * MiB;
constexpr size_t WS_SS1 = 20 * MiB + 65536;
constexpr size_t WS_LF = 21 * MiB;
constexpr size_t WS_CK2 = 22 * MiB;
constexpr size_t WS_XB = 24 * MiB;
constexpr size_t WS_Q0 = 56 * MiB;
constexpr size_t WS_K0 = 88 * MiB;
constexpr size_t WS_V0 = 120 * MiB;
constexpr size_t WS_G0 = 152 * MiB;
constexpr size_t WS_END = 184 * MiB;

struct P {
    const float* x; const int* positions; const float* norm_a_g; const float* w_in_a; const float* b_forget; const float* qnorm_a_g; const float* knorm_a_g;
    const float* w_out_a; const float* kv_norm_g; const float* w_kv; const float* knorm_b_g; const float* norm_b_g; const float* w_in_b; const float* qnorm_b_g;
    const float* sinks; const float* w_out_b;
    float* out; unsigned char* ws;
    double invf[8];
};

__device__ __forceinline__ unsigned f2bf(float f) { unsigned u = __builtin_bit_cast(unsigned, f); return (u + 0x7fffu + ((u >> 16) & 1u)) >> 16; }
__device__ __forceinline__ float bf2f(unsigned short h) { return __builtin_bit_cast(float, (unsigned)h << 16); }
__device__ __forceinline__ float wave_sum(float v) {
#pragma unroll
    for (int o = 1; o < 64; o <<= 1) v += __shfl_xor(v, o);
    return v;
}
__device__ __forceinline__ float silu_f(float v) { return v / (1.0f + __expf(-v)); }

__device__ __forceinline__ void sincos_d(double a, double& s, double& c) {
    const double TWO_PI = 6.283185307179586476925, INV = 0.15915494309189533577;
    const double n = rint(a * INV);
    const double r = fma(-n, TWO_PI, a), z = r * r;
    double ps = 1.0 / 8841761993739701954543616000000.0, pc = 1.0 / 304888344611713860501504000000.0;
    const double cs[14] = { -1.0 / 10888869450418352160768000000.0, 1.0 / 15511210043330985984000000.0, -1.0 / 25852016738884976640000.0, 1.0 / 51090942171709440000.0, -1.0 / 121645100408832000.0, 1.0 / 355687428096000.0, -1.0 / 1307674368000.0, 1.0 / 6227020800.0, -1.0 / 39916800.0, 1.0 / 362880.0, -1.0 / 5040.0, 1.0 / 120.0, -1.0 / 6.0, 1.0 / 1.0 };
    const double cc[14] = { -1.0 / 403291461126605635584000000.0, 1.0 / 620448401733239439360000.0, -1.0 / 1124000727777607680000.0, 1.0 / 2432902008176640000.0, -1.0 / 6402373705728000.0, 1.0 / 20922789888000.0, -1.0 / 87178291200.0, 1.0 / 479001600.0, -1.0 / 3628800.0, 1.0 / 40320.0, -1.0 / 720.0, 1.0 / 24.0, -1.0 / 2.0, 1.0 / 1.0 };
#pragma unroll
    for (int k = 0; k < 14; ++k) { ps = fma(ps, z, cs[k]); pc = fma(pc, z, cc[k]); }
    s = ps * r; c = pc;
}
__global__ void __launch_bounds__(256) k_prep_weights(P p) {
    bf16_t* WTA = (bf16_t*)(p.ws + WS_WTA); bf16_t* WTOA = (bf16_t*)(p.ws + WS_WTOA); bf16_t* WTB = (bf16_t*)(p.ws + WS_WTB); bf16_t* WTOB = (bf16_t*)(p.ws + WS_WTOB);
    float* WF = (float*)(p.ws + WS_WF); float* ROPE = (float*)(p.ws + WS_ROPE);
    const size_t n0 = (size_t)NA * 1024, n1 = n0 + 16 * 1024, n2 = n1 + (size_t)1024 * 1024, n3 = n2 + (size_t)NB * 1024, n4 = n3 + (size_t)1024 * 1024, n5 = n4 + 2048 * 8;
    for (size_t i = (size_t)blockIdx.x * 256 + threadIdx.x; i < n5; i += (size_t)gridDim.x * 256) {
        if (i < n0) { const int n = (int)(i >> 10), k = (int)(i & 1023); const int col = n < 3072 ? n : n + 16; WTA[i] = (bf16_t)f2bf(p.norm_a_g[k] * p.w_in_a[(size_t)k * WINA + col]); }
        else if (i < n1) { const size_t j = i - n0; const int h = (int)(j >> 10), k = (int)(j & 1023); WF[j] = p.norm_a_g[k] * p.w_in_a[(size_t)k * WINA + 3072 + h]; }
        else if (i < n2) { const size_t j = i - n1; const int n = (int)(j >> 10), k = (int)(j & 1023); WTOA[j] = (bf16_t)f2bf(p.w_out_a[(size_t)k * 1024 + n]); }
        else if (i < n3) { const size_t j = i - n2; const int n = (int)(j >> 10), k = (int)(j & 1023);
            const float v = n < 512 ? p.kv_norm_g[k] * p.w_kv[(size_t)k * 512 + n] : p.norm_b_g[k] * p.w_in_b[(size_t)k * 2048 + (n - 512)]; WTB[j] = (bf16_t)f2bf(v); }
        else if (i < n4) { const size_t j = i - n3; const int n = (int)(j >> 10), k = (int)(j & 1023); WTOB[j] = (bf16_t)f2bf(p.w_out_b[(size_t)k * 1024 + n]); }
        else { const size_t j = i - n4; const int s = (int)(j >> 3), f = (int)(j & 7); double sn, cs; sincos_d((double)p.positions[s] * p.invf[f], sn, cs); ROPE[j] = (float)cs; ROPE[2048 * 8 + j] = (float)sn; }
    }
}

__global__ void __launch_bounds__(256) k_prep_x(P p) {
    const int wave = threadIdx.x >> 6, lane = threadIdx.x & 63, m = blockIdx.x * 4 + wave;
    const float* WF = (const float*)(p.ws + WS_WF); bf16_t* XB = (bf16_t*)(p.ws + WS_XB); float* RS0 = (float*)(p.ws + WS_RS0); float* LF = (float*)(p.ws + WS_LF);
    const f32x4* xr = (const f32x4*)(p.x + (size_t)m * 1024);
    f32x4 v[4]; float ss = 0.f;
#pragma unroll
    for (int j = 0; j < 4; ++j) { v[j] = xr[lane + 64 * j]; ss += (v[j].x * v[j].x + v[j].y * v[j].y) + (v[j].z * v[j].z + v[j].w * v[j].w); }
    ss = wave_sum(ss);
    const float rstd = 1.0f / sqrtf(ss * (1.0f / 1024.0f) + EPS);
#pragma unroll
    for (int j = 0; j < 4; ++j) { uint2 o; o.x = f2bf(v[j].x) | (f2bf(v[j].y) << 16); o.y = f2bf(v[j].z) | (f2bf(v[j].w) << 16); *(uint2*)(XB + (size_t)m * 1024 + 4 * (lane + 64 * j)) = o; }
    float mine = 0.f;
#pragma unroll 1
    for (int h = 0; h < 16; ++h) {
        const f32x4* wr = (const f32x4*)(WF + h * 1024); float a = 0.f;
#pragma unroll
        for (int j = 0; j < 4; ++j) { const f32x4 w = wr[lane + 64 * j]; a += (v[j].x * w.x + v[j].y * w.y) + (v[j].z * w.z + v[j].w * w.w); }
        a = wave_sum(a); if (lane == h) mine = a;
    }
    if (lane < 16) { const float z = mine * rstd + p.b_forget[lane]; const float lf = fminf(z, 0.f) - log1pf(expf(-fabsf(z))); const int b = m / SEQ, s = m % SEQ; LF[((size_t)b * 16 + lane) * SEQ + s] = lf; }
    if (lane == 0) RS0[m] = rstd;
}

__global__ void __launch_bounds__(256) k_scan(P p) {
    __shared__ double wsum[4];
    const float* LF = (const float*)(p.ws + WS_LF); float* CK2 = (float*)(p.ws + WS_CK2);
    const int bh = blockIdx.x, tid = threadIdx.x, lane = tid & 63, wave = tid >> 6;
    const float* src = LF + (size_t)bh * SEQ + tid * 8;
    double loc[8]; double run = 0.0;
#pragma unroll
    for (int i = 0; i < 8; ++i) { run += (double)src[i]; loc[i] = run; }
    double incl = run;
#pragma unroll
    for (int o = 1; o < 64; o <<= 1) { const double t = __shfl_up(incl, o); if (lane >= o) incl += t; }
    if (lane == 63) wsum[wave] = incl;
    __syncthreads();
    double base = 0.0;
    for (int w = 0; w < wave; ++w) base += wsum[w];
    const double excl = base + incl - run;
#pragma unroll
    for (int i = 0; i < 8; ++i) CK2[(size_t)bh * SEQ + tid * 8 + i] = (float)((excl + loc[i]) * 1.4426950408889634);
}

template <int EPI> __global__ void __launch_bounds__(256) k_gemm_naive(P p) {
    const int wave = threadIdx.x >> 6, lane = threadIdx.x & 63, fr = lane & 15, fq = lane >> 4;
    const int row0 = 64 * blockIdx.y + 16 * wave, col0 = 64 * blockIdx.x, hb = blockIdx.x;
    const bf16_t* Ab = (const bf16_t*)(p.ws + (EPI == 0 ? WS_XB : EPI == 1 ? WS_Q0 : EPI == 2 ? WS_XB : WS_K0));
    const bf16_t* Bb = (const bf16_t*)(p.ws + (EPI == 0 ? WS_WTA : EPI == 1 ? WS_WTOA : EPI == 2 ? WS_WTB : WS_WTOB));
    const bf16_t* A = Ab + (size_t)(row0 + fr) * 1024 + 8 * fq;
    const bf16_t* B = Bb + (size_t)(col0 + fr) * 1024 + 8 * fq;
    f32x4 acc[4];
#pragma unroll
    for (int j = 0; j < 4; ++j) acc[j] = (f32x4){0.f, 0.f, 0.f, 0.f};
#pragma unroll 2
    for (int k0 = 0; k0 < 1024; k0 += 32) {
        const bf16x8 a = *(const bf16x8*)(A + k0);
#pragma unroll
        for (int j = 0; j < 4; ++j) { const bf16x8 b = *(const bf16x8*)(B + (size_t)16 * j * 1024 + k0); acc[j] = __builtin_amdgcn_mfma_f32_16x16x32_bf16(a, b, acc[j], 0, 0, 0); }
    }
    const float* ROPE = (const float*)(p.ws + WS_ROPE);
#pragma unroll
    for (int i = 0; i < 4; ++i) {
        const int r = row0 + 4 * fq + i;
        float v[4];
#pragma unroll
        for (int j = 0; j < 4; ++j) v[j] = acc[j][i];
        if (EPI == 0) {
            const float rs = ((const float*)(p.ws + WS_RS0))[r];
#pragma unroll
            for (int j = 0; j < 4; ++j) v[j] *= rs;
            if (hb < 32) {
                float ss = (v[0] * v[0] + v[1] * v[1]) + (v[2] * v[2] + v[3] * v[3]);
                ss += __shfl_xor(ss, 1); ss += __shfl_xor(ss, 2); ss += __shfl_xor(ss, 4); ss += __shfl_xor(ss, 8);
                const float hr = 1.0f / sqrtf(ss * (1.0f / 64.0f) + EPS);
                const float* g = hb < 16 ? p.qnorm_a_g : p.knorm_a_g; const float sc = hb < 16 ? C2 : 1.0f;
                bf16_t* dst = (bf16_t*)(p.ws + (hb < 16 ? WS_Q0 : WS_K0)) + (size_t)r * 1024 + (hb & 15) * 64;
#pragma unroll
                for (int j = 0; j < 4; ++j) dst[16 * j + fr] = (bf16_t)f2bf(v[j] * hr * g[16 * j + fr] * sc);
            } else if (hb < 48) {
                bf16_t* dst = (bf16_t*)(p.ws + WS_V0) + (size_t)r * 1024 + (hb - 32) * 64;
#pragma unroll
                for (int j = 0; j < 4; ++j) dst[16 * j + fr] = (bf16_t)f2bf(v[j]);
            } else {
                bf16_t* dst = (bf16_t*)(p.ws + WS_G0) + (size_t)r * 1024 + (hb - 48) * 64;
#pragma unroll
                for (int j = 0; j < 4; ++j) dst[16 * j + fr] = (bf16_t)f2bf(silu_f(v[j]));
            }
        } else if (EPI == 1) {
            bf16_t* HB = (bf16_t*)(p.ws + WS_XB);
#pragma unroll
            for (int j = 0; j < 4; ++j) { const size_t o = (size_t)r * 1024 + col0 + 16 * j + fr; const float h1 = p.x[o] + v[j]; p.out[o] = h1; HB[o] = (bf16_t)f2bf(h1); }
        } else if (EPI == 2) {
            const f32x4 pp = *(const f32x4*)((const float*)(p.ws + WS_SS1) + (size_t)r * 4);
            const float rs = 1.0f / sqrtf(((pp.x + pp.y) + (pp.z + pp.w)) * (1.0f / 1024.0f) + EPS);
#pragma unroll
            for (int j = 0; j < 4; ++j) v[j] *= rs;
            const bool isk = hb < 4, isq = hb >= 8 && hb < 24;
            if (isk || isq) {
                float ss = (v[0] * v[0] + v[1] * v[1]) + (v[2] * v[2] + v[3] * v[3]);
                ss += __shfl_xor(ss, 1); ss += __shfl_xor(ss, 2); ss += __shfl_xor(ss, 4); ss += __shfl_xor(ss, 8);
                const float hr = 1.0f / sqrtf(ss * (1.0f / 64.0f) + EPS);
                const float* g = isk ? p.knorm_b_g : p.qnorm_b_g; const float sc = isk ? 1.0f : C2;
                float y[4];
#pragma unroll
                for (int j = 0; j < 4; ++j) y[j] = v[j] * hr * g[16 * j + fr];
                { const float partner = __shfl_xor(y[0], 8); const int s = r % SEQ, f = fr & 7; const float cs = ROPE[s * 8 + f], sn = ROPE[2048 * 8 + s * 8 + f];
                  y[0] = fr < 8 ? y[0] * cs - partner * sn : partner * sn + y[0] * cs; }
                bf16_t* dst = isk ? (bf16_t*)(p.ws + WS_G0) + (size_t)r * KVW + hb * 64 : (bf16_t*)(p.ws + WS_K0) + (size_t)r * 1024 + (hb - 8) * 64;
#pragma unroll
                for (int j = 0; j < 4; ++j) dst[16 * j + fr] = (bf16_t)f2bf(y[j] * sc);
            } else if (hb < 8) {
                bf16_t* dst = (bf16_t*)(p.ws + WS_G0 + 8 * MiB) + (size_t)r * KVW + (hb - 4) * 64;
#pragma unroll
                for (int j = 0; j < 4; ++j) dst[16 * j + fr] = (bf16_t)f2bf(v[j]);
            } else {
                bf16_t* dst = (bf16_t*)(p.ws + WS_V0) + (size_t)r * 1024 + (hb - 24) * 64;
#pragma unroll
                for (int j = 0; j < 4; ++j) dst[16 * j + fr] = (bf16_t)f2bf(silu_f(v[j]));
            }
        } else {
#pragma unroll
            for (int j = 0; j < 4; ++j) { const size_t o = (size_t)r * 1024 + col0 + 16 * j + fr; p.out[o] = p.out[o] + v[j]; }
        }
    }
}

__global__ void __launch_bounds__(256) k_rowstat(P p) {
    const int wave = threadIdx.x >> 6, lane = threadIdx.x & 63, m = blockIdx.x * 4 + wave;
    const f32x4* xr = (const f32x4*)(p.out + (size_t)m * 1024); float ss = 0.f;
#pragma unroll
    for (int j = 0; j < 4; ++j) { const f32x4 v = xr[lane + 64 * j]; ss += (v.x * v.x + v.y * v.y) + (v.z * v.z + v.w * v.w); }
    ss = wave_sum(ss);
    if (lane == 0) *(f32x4*)((float*)(p.ws + WS_SS1) + (size_t)m * 4) = (f32x4){ss, 0.f, 0.f, 0.f};
}

template <int MODE> __global__ void __launch_bounds__(256) k_attn_naive(P p) {
    __shared__ __attribute__((aligned(16))) bf16_t Ks[64 * 64];
    __shared__ __attribute__((aligned(16))) bf16_t Vs[64 * 64];
    __shared__ float cks[64];
    const int t = threadIdx.x, qb = blockIdx.x, bh = blockIdx.y, b = bh >> 4, h = bh & 15;
    const int kvh = MODE ? (h >> 2) : h, kvp = MODE ? KVW : 1024;
    const bf16_t* Q = (const bf16_t*)(p.ws + (MODE ? WS_K0 : WS_Q0)); bf16_t* O = (bf16_t*)(p.ws + (MODE ? WS_K0 : WS_Q0));
    const bf16_t* K = (const bf16_t*)(p.ws + (MODE ? WS_G0 : WS_K0)); const bf16_t* V = (const bf16_t*)(p.ws + (MODE ? WS_G0 + 8 * MiB : WS_V0));
    const bf16_t* G = (const bf16_t*)(p.ws + (MODE ? WS_V0 : WS_G0));
    const float* CK2 = (const float*)(p.ws + WS_CK2);
    const int qrow = qb * 64 + (t >> 2), part = t & 3;
    const size_t qoff = ((size_t)b * SEQ + qrow) * 1024 + h * 64;
    float q[64], o[64];
#pragma unroll
    for (int d = 0; d < 64; d += 8) { const bf16x8 v = *(const bf16x8*)(Q + qoff + d);
#pragma unroll
        for (int e = 0; e < 8; ++e) q[d + e] = bf2f((unsigned short)v[e]); }
#pragma unroll
    for (int d = 0; d < 64; ++d) o[d] = 0.f;
    float l = 0.f;
    const float cq = MODE == 0 ? CK2[(size_t)bh * SEQ + qrow] : 0.f;
    const int kt0 = MODE ? (qb >= 2 ? qb - 2 : 0) : 0;
    for (int kt = kt0; kt <= qb; ++kt) {
        __syncthreads();
        { const int row = t >> 2, cs = (t & 3) * 16; const size_t ko = ((size_t)b * SEQ + kt * 64 + row) * kvp + kvh * 64 + cs;
          *(bf16x8*)(Ks + row * 64 + cs) = *(const bf16x8*)(K + ko); *(bf16x8*)(Ks + row * 64 + cs + 8) = *(const bf16x8*)(K + ko + 8);
          *(bf16x8*)(Vs + row * 64 + cs) = *(const bf16x8*)(V + ko); *(bf16x8*)(Vs + row * 64 + cs + 8) = *(const bf16x8*)(V + ko + 8);
          if (MODE == 0 && t < 64) cks[t] = CK2[(size_t)bh * SEQ + kt * 64 + t]; }
        __syncthreads();
#pragma unroll 1
        for (int kk = 0; kk < 16; ++kk) {
            const int key = part * 16 + kk, kpos = kt * 64 + key;
            float s = 0.f;
#pragma unroll
            for (int d = 0; d < 64; d += 8) { const bf16x8 kv = *(const bf16x8*)(Ks + key * 64 + d);
#pragma unroll
                for (int e = 0; e < 8; ++e) s += q[d + e] * bf2f((unsigned short)kv[e]); }
            if (MODE == 0) s += cq - cks[key];
            const bool valid = kpos <= qrow && (MODE == 0 || kpos > qrow - 128);
            const float pr = valid ? __builtin_amdgcn_exp2f(s) : 0.f;
            l += pr;
#pragma unroll
            for (int d = 0; d < 64; d += 8) { const bf16x8 vv = *(const bf16x8*)(Vs + key * 64 + d);
#pragma unroll
                for (int e = 0; e < 8; ++e) o[d + e] += pr * bf2f((unsigned short)vv[e]); }
        }
    }
    l += __shfl_xor(l, 1); l += __shfl_xor(l, 2);
#pragma unroll
    for (int d = 0; d < 64; ++d) { o[d] += __shfl_xor(o[d], 1); o[d] += __shfl_xor(o[d], 2); }
    if (MODE == 1) l += __builtin_amdgcn_exp2f(p.sinks[h] * LOG2E);
    const float rl = 1.0f / l;
#pragma unroll
    for (int d = 0; d < 64; ++d) if ((d >> 4) == part) O[qoff + d] = (bf16_t)f2bf(o[d] * rl * bf2f(G[qoff + d]));
}

namespace pg8 {
#define PG8_LAS __attribute__((address_space(3)))
typedef unsigned short bf16_t;
typedef short bf16x8 __attribute__((ext_vector_type(8)));
typedef float f32x4 __attribute__((ext_vector_type(4)));
typedef unsigned u32x4 __attribute__((ext_vector_type(4)));
constexpr int BM = 256, BK = 64, HALF = 128, HTB = HALF * BK * 2  , STAGE_BYTES = 8 * HTB, NXCD = 8, WGM = 8;

__host__ __device__ __forceinline__ int lds_byte(int r, int c) { const int st = (r >> 4) * 2 + (c >> 5), rr = r & 15, cc = c & 31, ob = rr * 64 + cc * 2; return st * 1024 + (ob ^ (((ob >> 9) & 1) << 5)); }
__host__ __device__ __forceinline__ void stage_rc(int b, int& R, int& C) { const int st = b / 1024, sb = b % 1024, swz = sb ^ (((sb >> 9) & 1) << 5); R = (st >> 1) * 16 + swz / 64; C = (st & 1) * 32 + (swz % 64) / 2; }
__host__ __device__ __forceinline__ int perm32(int rho) { const int n = rho >> 4, i = rho & 15; return 8 * (i >> 2) + 4 * n + (i & 3); }

struct Unit { int pm, pn; };
struct Gemm { const bf16_t* A; const bf16_t* Bt; int M, N, K; };

struct StaticOrder {
    int nM, nN, nwg, G, c;
    __host__ __device__ void init(int M, int N, int G_, int c_) { nM = M / BM; nN = N / BM; nwg = nM * nN; G = G_; c = c_; }
    __host__ __device__ bool next(int i, Unit& u) const {
        const long L = (long)i * G + c; if (L >= nwg) return false;
        int wgid = (int)L; { const int q = nwg / NXCD, r = nwg % NXCD, xcd = wgid % NXCD, off = wgid / NXCD; wgid = (xcd < r ? xcd * (q + 1) : r * (q + 1) + (xcd - r) * q) + off; }
        const int nig = WGM * nN, gid = wgid / nig, fm = gid * WGM, gsz = (nM - fm) < WGM ? (nM - fm) : WGM;
        u.pm = fm + ((wgid % nig) % gsz); u.pn = (wgid % nig) / gsz; return true;
    }
    __device__ __forceinline__ void a_ready(const Unit&) const {}
    __device__ __forceinline__ void done(const Unit&) const {}
};


typedef float f32x2_t __attribute__((ext_vector_type(2))); typedef __bf16 bf16x2_t __attribute__((ext_vector_type(2)));
__device__ __forceinline__ unsigned cvtpk(float lo, float hi) { f32x2_t v = {lo, hi}; bf16x2_t b = __builtin_convertvector(v, bf16x2_t); return __builtin_bit_cast(unsigned, b); }
__device__ __forceinline__ float silu1(float v) { return v * __builtin_amdgcn_rcpf(1.0f + __builtin_amdgcn_exp2f(-1.4426950408889634f * v)); }
constexpr float EPI_EPS = 1e-6f, EPI_C2 = 0.125f * 1.4426950408889634f;

template <int LAYER> struct EpiProj {
    static constexpr bool PERM = true, AFTER_DRAIN = false;
    const float* rs;
    const float* gq; const float* gk; const float* rope;
    bf16_t* base;
    PG8_LAS float* xch;
    __device__ __forceinline__ void operator()(f32x4 (&acc)[2][2][4][2], const Unit& u, int wr, int wc, int fr, int fq) const {
        int kind, tcol, pitch; size_t doff;
        constexpr size_t Mi = (size_t)1 << 20;
        if (LAYER == 0) { kind = u.pn >> 2; tcol = (u.pn & 3) * 256; pitch = 1024; doff = (size_t)kind * (16 * Mi); }
        else { if (u.pn == 0) { kind = 1; tcol = 0; pitch = 256; doff = 32 * Mi; } else if (u.pn == 1) { kind = 2; tcol = 0; pitch = 256; doff = 36 * Mi; }
               else if (u.pn < 6) { kind = 0; tcol = (u.pn - 2) * 256; pitch = 1024; doff = 0; } else { kind = 3; tcol = (u.pn - 6) * 256; pitch = 1024; doff = 16 * Mi; } }
        bf16_t* dst = base + doff;
        const int rowl0 = wr * 64 + fr, row0 = u.pm * BM + rowl0;
#pragma unroll
        for (int ai = 0; ai < 2; ++ai)
#pragma unroll
            for (int m = 0; m < 4; ++m) { const int r = row0 + ai * HALF + m * 16; float rsv;
                if (LAYER == 0) rsv = rs[r]; else { const f32x4 pp = *(const f32x4*)(rs + (size_t)r * 4); rsv = 1.0f / sqrtf(((pp[0] + pp[1]) + (pp[2] + pp[3])) * (1.0f / 1024.0f) + EPI_EPS); }
#pragma unroll
                for (int bj = 0; bj < 2; ++bj) { acc[ai][bj][m][0] *= rsv; acc[ai][bj][m][1] *= rsv; } }
        bf16_t* dcol = dst + tcol + wc * 32 + 8 * fq;
        if (kind <= 1) {
#pragma unroll
            for (int ai = 0; ai < 2; ++ai)
#pragma unroll
                for (int m = 0; m < 4; ++m)
#pragma unroll
                    for (int bj = 0; bj < 2; ++bj) { const f32x4 a = acc[ai][bj][m][0], b = acc[ai][bj][m][1];
                        float ss = ((a[0] * a[0] + a[1] * a[1]) + (a[2] * a[2] + a[3] * a[3])) + ((b[0] * b[0] + b[1] * b[1]) + (b[2] * b[2] + b[3] * b[3]));
                        ss += __shfl_xor(ss, 16); ss += __shfl_xor(ss, 32);
                        if (fq == 0) xch[((ai * HALF + rowl0 + m * 16) * 2 + bj) * 4 + wc] = ss; }
            asm volatile("s_waitcnt lgkmcnt(0)" ::: "memory"); __builtin_amdgcn_s_barrier(); asm volatile("" ::: "memory");
            const float* g = kind == 0 ? gq : gk; const float sc = kind == 0 ? EPI_C2 : 1.0f;
            const int d0 = 32 * (wc & 1) + 8 * fq;
            const f32x4 g0 = *(const f32x4*)(g + d0) * sc, g1 = *(const f32x4*)(g + d0 + 4) * sc;
            const bool rot = LAYER == 1 && (wc & 1) == 0;
#pragma unroll
            for (int ai = 0; ai < 2; ++ai)
#pragma unroll
                for (int m = 0; m < 4; ++m) { const int r = row0 + ai * HALF + m * 16;
                    f32x4 cs0 = {}, cs1 = {}, sn0 = {}, sn1 = {};
                    if (rot) { const float* rp = rope + (size_t)(r & 2047) * 8; cs0 = *(const f32x4*)rp; cs1 = *(const f32x4*)(rp + 4); sn0 = *(const f32x4*)(rp + 16384); sn1 = *(const f32x4*)(rp + 16384 + 4); }
#pragma unroll
                    for (int bj = 0; bj < 2; ++bj) { const f32x2_t pr = *(const PG8_LAS f32x2_t*)(xch + ((ai * HALF + rowl0 + m * 16) * 2 + bj) * 4 + (wc & 2)); const float tot = pr[0] + pr[1];
                        const float hr = 1.0f / sqrtf(tot * (1.0f / 64.0f) + EPI_EPS);
                        f32x4 y0 = acc[ai][bj][m][0] * hr * g0, y1 = acc[ai][bj][m][1] * hr * g1;
                        if (rot) { f32x4 p0, p1;
#pragma unroll
                            for (int i = 0; i < 4; ++i) { p0[i] = __shfl_xor(y0[i], 16); p1[i] = __shfl_xor(y1[i], 16); }
                            if (fq == 0) { y0 = y0 * cs0 - p0 * sn0; y1 = y1 * cs1 - p1 * sn1; }
                            else if (fq == 1) { y0 = p0 * sn0 + y0 * cs0; y1 = p1 * sn1 + y1 * cs1; } }
                        u32x4 w; w.x = cvtpk(y0[0], y0[1]); w.y = cvtpk(y0[2], y0[3]); w.z = cvtpk(y1[0], y1[1]); w.w = cvtpk(y1[2], y1[3]);
                        *(u32x4*)(dcol + (size_t)r * pitch + bj * HALF) = w; }
                    asm volatile("" ::: "memory"); }
        } else {
#pragma unroll
            for (int ai = 0; ai < 2; ++ai)
#pragma unroll
                for (int m = 0; m < 4; ++m) { const int r = row0 + ai * HALF + m * 16;
#pragma unroll
                    for (int bj = 0; bj < 2; ++bj) { f32x4 y0 = acc[ai][bj][m][0], y1 = acc[ai][bj][m][1];
                        if (kind == 3) {
#pragma unroll
                            for (int i = 0; i < 4; ++i) { y0[i] = silu1(y0[i]); y1[i] = silu1(y1[i]); } }
                        u32x4 w; w.x = cvtpk(y0[0], y0[1]); w.y = cvtpk(y0[2], y0[3]); w.z = cvtpk(y1[0], y1[1]); w.w = cvtpk(y1[2], y1[3]);
                        *(u32x4*)(dcol + (size_t)r * pitch + bj * HALF) = w; } }
        }
    }
};

struct EpiRes1 {
    static constexpr bool PERM = false, AFTER_DRAIN = true;
    static constexpr int LATE_STORES = 32;
    const float* x; float* out; bf16_t* hb; float* ss1;
    __device__ __forceinline__ void fused(f32x4 (&acc)[2][2][4][2], const Unit& u, int wr, int wc, int fr, int fq, PG8_LAS unsigned char* lds, int wid, int lane) const {
        PG8_LAS float* Pp = (PG8_LAS float*)lds;
        const int col0 = u.pn * BM + wc * 32 + 4 * fq;
#pragma unroll
        for (int ai = 0; ai < 2; ++ai)
#pragma unroll
            for (int m = 0; m < 4; ++m) { const int rl = ai * HALF + wr * 64 + m * 16 + fr; const size_t off = (size_t)(u.pm * BM + rl) * 1024 + col0; float ss = 0.f;
#pragma unroll
                for (int bj = 0; bj < 2; ++bj)
#pragma unroll
                    for (int n = 0; n < 2; ++n) { const f32x4 h = *(const f32x4*)(x + off + bj * HALF + n * 16) + acc[ai][bj][m][n]; acc[ai][bj][m][n] = h;
                        ss += (h[0] * h[0] + h[1] * h[1]) + (h[2] * h[2] + h[3] * h[3]);
                        unsigned w0 = cvtpk(h[0], h[1]), w1 = cvtpk(h[2], h[3]); *(unsigned long long*)(hb + off + bj * HALF + n * 16) = (unsigned long long)w0 | ((unsigned long long)w1 << 32); }
                ss += __shfl_xor(ss, 16); ss += __shfl_xor(ss, 32);
                if (fq == 0) Pp[rl * 4 + wc] = ss;
                if (m & 1) asm volatile("" ::: "memory"); }
        asm volatile("s_waitcnt lgkmcnt(0)" ::: "memory"); __builtin_amdgcn_s_barrier(); asm volatile("" ::: "memory");
        const int t = wid * 64 + lane;
        if (t < 256) { const f32x4 pp = *(const PG8_LAS f32x4*)(Pp + t * 4); ss1[(size_t)(u.pm * BM + t) * 4 + u.pn] = (pp[0] + pp[1]) + (pp[2] + pp[3]); }
        asm volatile("" ::: "memory");
#pragma unroll
        for (int ai = 0; ai < 2; ++ai)
#pragma unroll
            for (int m = 0; m < 4; ++m) { const size_t off = (size_t)(u.pm * BM + ai * HALF + wr * 64 + m * 16 + fr) * 1024 + col0;
#pragma unroll
                for (int bj = 0; bj < 2; ++bj)
#pragma unroll
                    for (int n = 0; n < 2; ++n) *(f32x4*)(out + off + bj * HALF + n * 16) = acc[ai][bj][m][n]; }
        asm volatile("" ::: "memory");
    }
};
struct EpiRes2 {
    static constexpr bool PERM = false, AFTER_DRAIN = true;
    float* out;
    __device__ __forceinline__ void fused(f32x4 (&acc)[2][2][4][2], const Unit& u, int wr, int wc, int fr, int fq, PG8_LAS unsigned char* lds, int wid, int lane) const {
        const int col0 = u.pn * BM + wc * 32 + 4 * fq;
#pragma unroll
        for (int ai = 0; ai < 2; ++ai)
#pragma unroll
            for (int m = 0; m < 4; ++m) { const size_t off = (size_t)(u.pm * BM + ai * HALF + wr * 64 + m * 16 + fr) * 1024 + col0;
#pragma unroll
                for (int bj = 0; bj < 2; ++bj)
#pragma unroll
                    for (int n = 0; n < 2; ++n) { float* o = out + off + bj * HALF + n * 16; *(f32x4*)o = *(const f32x4*)o + acc[ai][bj][m][n]; }
                if (m & 1) asm volatile("" ::: "memory"); }
    }
};

template <class Epi, class Sched, bool ALIGN_EPI = false, bool SP2 = false>
__device__ __forceinline__ void gemm_phase(PG8_LAS unsigned char* lds, const Gemm g, const Sched& S, const Epi& E) {
    int tid_ = threadIdx.x; asm volatile("" : "+v"(tid_));
    const int tid = tid_, wid = __builtin_amdgcn_readfirstlane(tid >> 6), lane = tid & 63, wr = wid >> 2, wc = wid & 3, fr = lane & 15, fq = lane >> 4;
    const int K = g.K, nt = K / BK;
    unsigned voffA[2], voffB[2];
#pragma unroll
    for (int i = 0; i < 2; ++i) { int R, C; stage_rc(tid * 16 + i * 8192, R, C); const int Rb = Epi::PERM ? ((R & ~31) + perm32(R & 31)) : R;
        voffA[i] = (unsigned)(R * K + C) * 2u; voffB[i] = (unsigned)(Rb * K + C) * 2u; }
    const size_t kstep = (size_t)(BK * 2);
    const size_t hstep = (size_t)HALF * K * 2;
    const size_t tstep = 2 * hstep;
    const unsigned ldsw = (unsigned)wid * 1024u;
    const int aoff = lds_byte(wr * 64 + fr, fq * 8), boff = lds_byte(wc * 32 + fr, fq * 8);
#define PG8_SA(b, h) (((b) * 2 + (h)) * HTB)
#define PG8_SB(b, h) ((4 + (b) * 2 + (h)) * HTB)
#define PG8_STAGE(bufoff, gbase, voff) do { _Pragma("unroll") for (int _i = 0; _i < 2; ++_i) \
        __builtin_amdgcn_global_load_lds((const unsigned*)((const char*)(gbase) + (voff)[_i]), (PG8_LAS unsigned*)(lds + (bufoff) + ldsw + _i * 8192), 16, 0, 0); } while (0)
#define PG8_LDA(dst, b, h) do { _Pragma("unroll") for (int m = 0; m < 4; ++m) _Pragma("unroll") for (int k = 0; k < 2; ++k) dst[m][k] = *(const PG8_LAS bf16x8*)(lds + PG8_SA(b, h) + aoff + m * 2048 + k * 1024); } while (0)
#define PG8_LDB(dst, b, h) do { _Pragma("unroll") for (int n = 0; n < 2; ++n) _Pragma("unroll") for (int k = 0; k < 2; ++k) dst[n][k] = *(const PG8_LAS bf16x8*)(lds + PG8_SB(b, h) + boff + n * 2048 + k * 1024); } while (0)
#define PG8_MMA(ai, bj, At, Bt) do { __builtin_amdgcn_s_setprio(1); _Pragma("unroll") for (int m = 0; m < 4; ++m) _Pragma("unroll") for (int n = 0; n < 2; ++n) _Pragma("unroll") for (int k = 0; k < 2; ++k) \
        acc[ai][bj][m][n] = __builtin_amdgcn_mfma_f32_16x16x32_bf16(Bt[n][k], At[m][k], acc[ai][bj][m][n], 0, 0, 0); __builtin_amdgcn_s_setprio(0); } while (0)
#define PG8_WAIT_V(n) asm volatile("s_waitcnt vmcnt(" #n ")" ::: "memory")
#define PG8_WAIT_L(n) asm volatile("s_waitcnt lgkmcnt(" #n ")" ::: "memory")
#define PG8_BAR __builtin_amdgcn_s_barrier()
#define PG8_SCHED __builtin_amdgcn_sched_barrier(0)
    Unit cur, nxt; int ui = 0;
    if (!S.next(0, cur)) return;
    f32x4 acc[2][2][4][2];
#pragma unroll
    for (int a = 0; a < 2; ++a)
#pragma unroll
        for (int b = 0; b < 2; ++b)
#pragma unroll
            for (int m = 0; m < 4; ++m)
#pragma unroll
                for (int n = 0; n < 2; ++n) acc[a][b][m][n] = (f32x4){0.f, 0.f, 0.f, 0.f};
    bf16x8 At[4][2], B0[2][2], B1[2][2];
    const char* cA = (const char*)g.A + (size_t)cur.pm * tstep; const char* cB = (const char*)g.Bt + (size_t)cur.pn * tstep;
    S.a_ready(cur);
    if constexpr (SP2) {
        PG8_STAGE(PG8_SB(0, 0), cB, voffB); PG8_STAGE(PG8_SB(0, 1), cB + hstep, voffB); PG8_STAGE(PG8_SA(0, 0), cA, voffA); PG8_STAGE(PG8_SA(0, 1), cA + hstep, voffA);
        if (wr == 1) PG8_BAR;
        PG8_WAIT_V(2); PG8_BAR;
        PG8_STAGE(PG8_SB(1, 0), cB + kstep, voffB); PG8_STAGE(PG8_SA(1, 0), cA + kstep, voffA); PG8_STAGE(PG8_SB(1, 1), cB + hstep + kstep, voffB);
        PG8_WAIT_V(6); PG8_BAR;
    } else {
        PG8_STAGE(PG8_SB(0, 0), cB, voffB); PG8_STAGE(PG8_SA(0, 0), cA, voffA); PG8_STAGE(PG8_SB(0, 1), cB + hstep, voffB); PG8_STAGE(PG8_SA(0, 1), cA + hstep, voffA);
        if (wr == 1) PG8_BAR;
        PG8_WAIT_V(4); PG8_BAR;
        PG8_STAGE(PG8_SB(1, 0), cB + kstep, voffB); PG8_STAGE(PG8_SA(1, 0), cA + kstep, voffA); PG8_STAGE(PG8_SB(1, 1), cB + hstep + kstep, voffB);
        PG8_WAIT_V(6); PG8_BAR;
    }
    for (;;) {
        const bool has_next = S.next(ui + 1, nxt);
        const char* nA = has_next ? (const char*)g.A + (size_t)nxt.pm * tstep : cA; const char* nB = has_next ? (const char*)g.Bt + (size_t)nxt.pn * tstep : cB;
        for (int t = 0; t < nt; t += 2) {
            const bool last = (t == nt - 2);
            const char* a1 = cA + (size_t)(t + 1) * kstep;
            const char* a2 = last ? nA : cA + (size_t)(t + 2) * kstep; const char* b2 = last ? nB : cB + (size_t)(t + 2) * kstep;
            const char* a3 = a2 + kstep; const char* b3 = b2 + kstep;
            if (last && has_next) S.a_ready(nxt);
            if constexpr (SP2) {
            PG8_LDB(B0, 0, 0); PG8_LDB(B1, 0, 1); PG8_SCHED; PG8_LDA(At, 0, 0); PG8_STAGE(PG8_SA(1, 1), a1 + hstep, voffA);
            PG8_WAIT_V(8); PG8_WAIT_L(0); PG8_BAR; PG8_MMA(0, 0, At, B0); PG8_MMA(0, 1, At, B1); PG8_BAR; PG8_SCHED;
            PG8_LDA(At, 0, 1); PG8_STAGE(PG8_SB(0, 0), b2, voffB); PG8_STAGE(PG8_SB(0, 1), b2 + hstep, voffB); PG8_STAGE(PG8_SA(0, 0), a2, voffA);
            PG8_WAIT_V(8); PG8_WAIT_L(0); PG8_BAR; PG8_MMA(1, 0, At, B0); PG8_MMA(1, 1, At, B1); PG8_BAR; PG8_SCHED;
            PG8_LDB(B0, 1, 0); PG8_LDB(B1, 1, 1); PG8_SCHED; PG8_LDA(At, 1, 0); PG8_STAGE(PG8_SA(0, 1), a2 + hstep, voffA);
            PG8_WAIT_V(8); PG8_WAIT_L(0); PG8_BAR; PG8_MMA(0, 0, At, B0); PG8_MMA(0, 1, At, B1); PG8_BAR; PG8_SCHED;
            PG8_LDA(At, 1, 1); PG8_STAGE(PG8_SB(1, 0), b3, voffB); PG8_STAGE(PG8_SB(1, 1), b3 + hstep, voffB); PG8_STAGE(PG8_SA(1, 0), a3, voffA);
            PG8_WAIT_V(8); PG8_WAIT_L(0); PG8_BAR; PG8_MMA(1, 0, At, B0); PG8_MMA(1, 1, At, B1); PG8_BAR; PG8_SCHED;
            } else {
            PG8_LDB(B0, 0, 0); PG8_SCHED; PG8_LDA(At, 0, 0); PG8_STAGE(PG8_SA(1, 1), a1 + hstep, voffA);
            PG8_WAIT_L(8); PG8_BAR; PG8_WAIT_L(0); PG8_MMA(0, 0, At, B0); PG8_BAR; PG8_SCHED;
            PG8_LDB(B1, 0, 1); PG8_STAGE(PG8_SB(0, 0), b2, voffB);
            PG8_BAR; PG8_WAIT_L(0); PG8_MMA(0, 1, At, B1); PG8_BAR;
            PG8_LDA(At, 0, 1); PG8_STAGE(PG8_SA(0, 0), a2, voffA);
            PG8_BAR; PG8_WAIT_L(0); PG8_MMA(1, 0, At, B0); PG8_BAR; PG8_SCHED;
            PG8_STAGE(PG8_SB(0, 1), b2 + hstep, voffB);
            PG8_WAIT_V(6); PG8_BAR; PG8_MMA(1, 1, At, B1); PG8_BAR;
            PG8_LDB(B0, 1, 0); PG8_SCHED; PG8_LDA(At, 1, 0); PG8_STAGE(PG8_SA(0, 1), a2 + hstep, voffA);
            PG8_WAIT_L(8); PG8_BAR; PG8_WAIT_L(0); PG8_MMA(0, 0, At, B0); PG8_BAR; PG8_SCHED;
            PG8_LDB(B1, 1, 1); PG8_STAGE(PG8_SB(1, 0), b3, voffB);
            PG8_BAR; PG8_WAIT_L(0); PG8_MMA(0, 1, At, B1); PG8_BAR;
            PG8_LDA(At, 1, 1); PG8_STAGE(PG8_SA(1, 0), a3, voffA);
            PG8_BAR; PG8_WAIT_L(0); PG8_MMA(1, 0, At, B0); PG8_BAR; PG8_SCHED;
            PG8_STAGE(PG8_SB(1, 1), b3 + hstep, voffB);
            PG8_WAIT_V(6); PG8_BAR; PG8_MMA(1, 1, At, B1); PG8_BAR;
            }
        }
        if constexpr (ALIGN_EPI) { if (wr == 0) PG8_BAR; }
        if constexpr (!Epi::AFTER_DRAIN) { E(acc, cur, wr, wc, fr, fq); S.done(cur); }
        if (!has_next) break;
#pragma unroll
        for (int a = 0; a < 2; ++a)
#pragma unroll
            for (int b = 0; b < 2; ++b)
#pragma unroll
                for (int m = 0; m < 4; ++m)
#pragma unroll
                    for (int n = 0; n < 2; ++n) acc[a][b][m][n] = (f32x4){0.f, 0.f, 0.f, 0.f};
        cur = nxt; cA = nA; cB = nB; ++ui;
        if constexpr (ALIGN_EPI) { if (wr == 1) PG8_BAR; }
    }
    PG8_WAIT_V(0);
    if constexpr (!ALIGN_EPI) { if (wr == 0) PG8_BAR; }
    PG8_BAR;
    if constexpr (Epi::AFTER_DRAIN) { E.fused(acc, cur, wr, wc, fr, fq, lds, wid, lane); S.done(cur); }
#undef PG8_SA
#undef PG8_SB
#undef PG8_STAGE
#undef PG8_LDA
#undef PG8_LDB
#undef PG8_MMA
#undef PG8_WAIT_V
#undef PG8_WAIT_L
#undef PG8_BAR
#undef PG8_SCHED
}
}

namespace attn_body {
using bf16 = unsigned short;
using bf16x8 = __attribute__((ext_vector_type(8))) short;
using s16x4 = __attribute__((ext_vector_type(4))) short;
using f32x16 = __attribute__((ext_vector_type(16))) float;
using f32x4 = __attribute__((ext_vector_type(4))) float;
using u32x4 = __attribute__((ext_vector_type(4))) unsigned;
constexpr int SEQ = 2048, D = 64, DM = 1024;
constexpr int NW = 8, QBLK = 32, QB = QBLK * NW, KVBLK = 64;
__device__ __forceinline__ int crow(int r, int hi) { return (r & 3) + 8 * (r >> 2) + 4 * hi; }
#define SBAR() __builtin_amdgcn_sched_barrier(0)
template <int MODE> __device__ __forceinline__ void amask(f32x16& p0, f32x16& p1, int d) {
  const float NEG = -INFINITY; asm volatile("" : "+v"(d)); const int d2 = d - 128;
  #pragma unroll
  for (int r = 0; r < 16; ++r) { const int c = (r & 3) + 8 * (r >> 2);
    if (MODE == 0) { if (c > d) p0[r] = NEG; if (c + 32 > d) p1[r] = NEG; }
    else { if (c > d || c <= d2) p0[r] = NEG; if (c + 32 > d || c + 32 <= d2) p1[r] = NEG; } }
}
constexpr int NSLOT = 3, SLOTB = 8192;
constexpr int LDS_K = 0, LDS_V = NSLOT * SLOTB, LDS_WS = 2 * NSLOT * SLOTB, LDS_BU = LDS_WS + NW * 64 * 4, LDS_OST = LDS_BU + 8192, LDS_BYTES = LDS_OST + NW * 8192;
__device__ __forceinline__ void glds16(const void* sbase, unsigned voff, unsigned lds_dst) { unsigned keep;
  asm volatile("s_nop 4\n\ts_mov_b32 %0, m0\n\ts_mov_b32 m0, %3\n\ts_nop 0\n\tglobal_load_lds_dwordx4 %1, %2\n\ts_mov_b32 m0, %0" : "=&s"(keep) : "v"(voff), "s"(sbase), "s"(lds_dst) : "memory"); }
typedef float f32x2_t __attribute__((ext_vector_type(2))); typedef __bf16 bf16x2_t __attribute__((ext_vector_type(2)));
__device__ __forceinline__ unsigned cvtpk_s(float lo, float hi) { f32x2_t v = {lo, hi}; bf16x2_t b = __builtin_convertvector(v, bf16x2_t); return __builtin_bit_cast(unsigned, b); }
#define WAIT_BAR(N) asm volatile("s_waitcnt vmcnt(" #N ") lgkmcnt(0)\n\ts_barrier" ::: "memory")
typedef __attribute__((address_space(3))) const char* lds_cptr;
typedef short v4i16_t __attribute__((ext_vector_type(4)));
__device__ __forceinline__ void kload8(bf16x8* kf, lds_cptr kp) {
  kf[0] = *(const __attribute__((address_space(3))) bf16x8*)(kp);        kf[1] = *(const __attribute__((address_space(3))) bf16x8*)(kp + 512);
  kf[2] = *(const __attribute__((address_space(3))) bf16x8*)(kp + 2048); kf[3] = *(const __attribute__((address_space(3))) bf16x8*)(kp + 2560);
  kf[4] = *(const __attribute__((address_space(3))) bf16x8*)(kp + 4096); kf[5] = *(const __attribute__((address_space(3))) bf16x8*)(kp + 4608);
  kf[6] = *(const __attribute__((address_space(3))) bf16x8*)(kp + 6144); kf[7] = *(const __attribute__((address_space(3))) bf16x8*)(kp + 6656);
}
__device__ __forceinline__ void kload2(bf16x8* kf, lds_cptr kp, int j) { kf[2 * j] = *(const __attribute__((address_space(3))) bf16x8*)(kp + j * 2048); kf[2 * j + 1] = *(const __attribute__((address_space(3))) bf16x8*)(kp + j * 2048 + 512); }
__device__ __forceinline__ s16x4 vtr(lds_cptr p) { return __builtin_bit_cast(s16x4, __builtin_amdgcn_ds_read_tr16_b64_v4i16((__attribute__((address_space(3))) v4i16_t*)p)); }
__device__ __forceinline__ void pv(f32x16* o, int vb, bf16x8 pa0, bf16x8 pa1, bf16x8 pa2, bf16x8 pa3) {
  #pragma unroll
  for (int d0 = 0; d0 < 2; ++d0) { s16x4 lo[4], hi[4];
    #pragma unroll
    for (int ks = 0; ks < 4; ++ks) {
      asm volatile("ds_read_b64_tr_b16 %0,%1 offset:%c2" : "=&v"(lo[ks]) : "v"(vb), "i"(d0 * 4096 + ks * 1024) : "memory");
      asm volatile("ds_read_b64_tr_b16 %0,%1 offset:%c2" : "=&v"(hi[ks]) : "v"(vb), "i"(d0 * 4096 + ks * 1024 + 512) : "memory"); }
    asm volatile("s_waitcnt lgkmcnt(0)" ::: "memory"); SBAR();
    #define PK(k) (bf16x8){lo[k][0], lo[k][1], lo[k][2], lo[k][3], hi[k][0], hi[k][1], hi[k][2], hi[k][3]}
    o[d0] = __builtin_amdgcn_mfma_f32_32x32x16_bf16(pa0, PK(0), o[d0], 0, 0, 0);
    o[d0] = __builtin_amdgcn_mfma_f32_32x32x16_bf16(pa1, PK(1), o[d0], 0, 0, 0);
    o[d0] = __builtin_amdgcn_mfma_f32_32x32x16_bf16(pa2, PK(2), o[d0], 0, 0, 0);
    o[d0] = __builtin_amdgcn_mfma_f32_32x32x16_bf16(pa3, PK(3), o[d0], 0, 0, 0);
    #undef PK
  }
}

struct AUnit { int b, hq, qb;
  template <int MODE> __device__ __forceinline__ int kvh() const { return MODE ? (hq >> 2) : hq; }
  template <int MODE> __device__ __forceinline__ int q0() const { return MODE ? 128 * qb : 256 * qb; }
  template <int MODE> __device__ __forceinline__ int T0() const { return MODE ? (qb > 0 ? 2 * qb - 2 : 0) : 0; } };
struct APtrs { const bf16* Q; const bf16* K; const bf16* V; const bf16* G; bf16* O; };
template <int MODE> __device__ __forceinline__ APtrs attn_ptrs(unsigned char* ws, bool dry) {
  constexpr size_t Mi = (size_t)1 << 20; APtrs a;
  if (MODE == 0) { a.Q = (const bf16*)(ws + 56 * Mi); a.K = (const bf16*)(ws + 88 * Mi); a.V = (const bf16*)(ws + 120 * Mi); a.G = (const bf16*)(ws + 152 * Mi); }
  else { a.Q = (const bf16*)(ws + 88 * Mi); a.K = (const bf16*)(ws + 152 * Mi); a.V = (const bf16*)(ws + 160 * Mi); a.G = (const bf16*)(ws + 120 * Mi); }
  a.O = dry ? (bf16*)(ws + 184 * Mi) : (bf16*)a.Q; return a;
}
__device__ __forceinline__ void bias_table(const __attribute__((address_space(3))) float* ctab, char* shm, int nk, int tid) {
  const float cref = ctab[nk - 1]; const int k0 = tid * 4;
  if (k0 < nk) { const f32x4 c = *(const __attribute__((address_space(3))) f32x4*)(ctab + k0); *(f32x4*)((float*)(shm + LDS_BU) + k0) = (f32x4){cref, cref, cref, cref} - c; }
}
template <int MODE> __device__ __forceinline__ void attn_start(const AUnit u, bf16x8 (&qr)[4], unsigned char* ws, char* shm) {
  constexpr int KP = MODE ? 256 : 1024; const APtrs A = attn_ptrs<MODE>(ws, false); const bf16* Q = A.Q; const bf16* K = A.K; const bf16* V = A.V;
  const int tid = threadIdx.x, lane = tid & 63, r32 = lane & 31, hi = lane >> 5; const int wid = __builtin_amdgcn_readfirstlane(tid >> 6);
  const int hw = MODE ? u.hq + (wid >> 2) : u.hq, rw = MODE ? 32 * (wid & 3) : 32 * wid;
  const long rowbase = (long)u.b * SEQ;
  const bf16* Kh = K + (rowbase + (long)u.T0<MODE>() * KVBLK) * KP + u.kvh<MODE>() * D, *Vh = V + (rowbase + (long)u.T0<MODE>() * KVBLK) * KP + u.kvh<MODE>() * D;
  const unsigned lds0 = (unsigned)(uintptr_t)shm;
  const unsigned koff = (unsigned)(lane * KP + wid * 8) * 2u, voff = (unsigned)((16 * (wid & 3) + (lane >> 2)) * KP + (wid >> 2) * 32 + (lane & 3) * 8) * 2u;
  const unsigned kdst = lds0 + LDS_K + wid * 1024, vdst = lds0 + LDS_V + wid * 1024;
  glds16(Kh, koff, (unsigned)__builtin_amdgcn_readfirstlane(kdst)); glds16(Vh, voff, (unsigned)__builtin_amdgcn_readfirstlane(vdst));
  glds16(Kh + (long)KVBLK * KP, koff, (unsigned)__builtin_amdgcn_readfirstlane(kdst + SLOTB)); glds16(Kh + 2L * KVBLK * KP, koff, (unsigned)__builtin_amdgcn_readfirstlane(kdst + 2 * SLOTB));
  const bf16* Qw = Q + (rowbase + u.q0<MODE>() + rw) * DM + hw * D;
  #pragma unroll
  for (int d0 = 0; d0 < 4; ++d0) qr[d0] = *reinterpret_cast<const bf16x8*>(&Qw[(long)r32 * DM + d0 * 16 + hi * 8]);
}
template <int MODE> __device__ __forceinline__ void attn_unit(const AUnit u, const AUnit un, bool has_next, bool dry, bf16x8 (&qr)[4], unsigned char* ws, const __attribute__((address_space(3))) float* ctab, const float* sinks, char* shm) {
  constexpr int KP = MODE ? 256 : 1024;
  const APtrs A = attn_ptrs<MODE>(ws, dry); const bf16* Q = A.Q; const bf16* K = A.K; const bf16* V = A.V; const bf16* G = A.G; bf16* O = A.O;
  constexpr int QROWS = MODE ? 128 : 256;
  int tid_ = threadIdx.x; asm volatile("" : "+v"(tid_));
  const int tid = tid_, lane = tid & 63, r32 = lane & 31, hi = lane >> 5; const int wid = __builtin_amdgcn_readfirstlane(tid >> 6);
  const int hw = MODE ? u.hq + (wid >> 2) : u.hq, rw = MODE ? 32 * (wid & 3) : 32 * wid;
  const long rowbase = (long)u.b * SEQ; const int q0 = u.q0<MODE>(), T0 = u.T0<MODE>();
  const int NT = (q0 + QROWS) / KVBLK - T0;
  const bf16* Kh = K + (rowbase + (long)T0 * KVBLK) * KP + u.kvh<MODE>() * D, *Vh = V + (rowbase + (long)T0 * KVBLK) * KP + u.kvh<MODE>() * D;
  const unsigned lds0 = (unsigned)(uintptr_t)shm;
  const lds_cptr shm3 = (lds_cptr)shm;
  const unsigned koff = (unsigned)(lane * KP + wid * 8) * 2u;
  const unsigned voff = (unsigned)((16 * (wid & 3) + (lane >> 2)) * KP + (wid >> 2) * 32 + (lane & 3) * 8) * 2u;
  const unsigned kdst = lds0 + LDS_K + wid * 1024, vdst = lds0 + LDS_V + wid * 1024;
  #define DMA_K(t, slot) glds16(Kh + (long)(t) * KVBLK * KP, koff, (unsigned)__builtin_amdgcn_readfirstlane(kdst + (slot)))
  #define DMA_V(t, slot) glds16(Vh + (long)(t) * KVBLK * KP, voff, (unsigned)__builtin_amdgcn_readfirstlane(vdst + (slot)))
  const int vb0 = (int)(lds0 + LDS_V) + ((lane >> 4) & 1) * 32 + (lane & 3) * 8 + (4 * hi + ((lane & 15) >> 2)) * 64;
  bf16x8 kf[8];
  const lds_cptr kp0 = shm3 + LDS_K + hi * 1024 + r32 * 16; const lds_cptr vp0 = shm3 + LDS_V + ((lane >> 4) & 1) * 32 + (lane & 3) * 8 + (4 * hi + ((lane & 15) >> 2)) * 64;
  const __attribute__((address_space(3))) f32x4* bup = (const __attribute__((address_space(3))) f32x4*)(shm3 + LDS_BU) + hi;
  float l_reg = 0.f; f32x16 o[2]; o[0] = f32x16{}; o[1] = f32x16{};
  const int dq = rw + r32 - (T0 * KVBLK - q0) - 4 * hi;
  #define CMASK(P0, P1, t) do { if (MODE == 1 || (t) >= NT - 4) amask<MODE>(P0, P1, dq - 64 * (t)); } while (0)
  #define MFMA32(a, b, c) __builtin_amdgcn_mfma_f32_32x32x16_bf16(a, b, c, 0, 0, 0)
  #define CI(X) (MODE ? f32x16{} : (X))
  #define BLD(P, base, j0) do { if (MODE == 0) { const f32x4 u_ = bup[(base) + 2 * (j0)], v_ = bup[(base) + 2 * (j0) + 2]; \
      P[4 * (j0)] = u_[0]; P[4 * (j0) + 1] = u_[1]; P[4 * (j0) + 2] = u_[2]; P[4 * (j0) + 3] = u_[3]; P[4 * (j0) + 4] = v_[0]; P[4 * (j0) + 5] = v_[1]; P[4 * (j0) + 6] = v_[2]; P[4 * (j0) + 7] = v_[3]; } } while (0)
  f32x16 pA0, pA1, pB0, pB1;
  int sl_prev = 0, sl_cur = 0, sl_next = SLOTB;
  #define ROT() do { sl_prev = sl_cur; sl_cur = sl_next; sl_next = (sl_next == (NSLOT - 1) * SLOTB) ? 0 : sl_next + SLOTB; } while (0)
  WAIT_BAR(3);
  if (MODE == 0) { BLD(pA0, 0, 0); BLD(pA0, 0, 2); BLD(pA1, 8, 0); BLD(pA1, 8, 2); }
  { const char* kb = shm + LDS_K + hi * 1024 + r32 * 16;
    #pragma unroll
    for (int d0 = 0; d0 < 4; ++d0) {
      const bf16x8 b0 = *reinterpret_cast<const bf16x8*>(kb + d0 * 2048);
      const bf16x8 b1 = *reinterpret_cast<const bf16x8*>(kb + d0 * 2048 + 512);
      if (d0 == 0) { pA0 = MFMA32(b0, qr[0], CI(pA0)); pA1 = MFMA32(b1, qr[0], CI(pA1)); }
      else { pA0 = MFMA32(b0, qr[d0], pA0); pA1 = MFMA32(b1, qr[d0], pA1); } } }
  CMASK(pA0, pA1, 0);
  _Pragma("unroll") for (int r = 0; r < 16; ++r) { pA0[r] = __builtin_amdgcn_exp2f(pA0[r]); pA1[r] = __builtin_amdgcn_exp2f(pA1[r]); }
  WAIT_BAR(0);
  DMA_K(3, 0); DMA_V(1, SLOTB);
  ROT();
  kload8(kf, kp0 + sl_cur);
  if (MODE == 0) { BLD(pB0, 16, 0); BLD(pB0, 16, 2); BLD(pB1, 24, 0); BLD(pB1, 24, 2); }
  WAIT_BAR(2);
  s16x4 vlo[8], vhi[8]; u32x4 pw0, pw1, pw2, pw3;
  #define PKW(P, B) cvtpk_s(P[B], P[B + 1])
  #define PAF(k) __builtin_bit_cast(bf16x8, pw##k)
  #define VFR(i) (bf16x8){vlo[i][0], vlo[i][1], vlo[i][2], vlo[i][3], vhi[i][0], vhi[i][1], vhi[i][2], vhi[i][3]}
  #define PIN(x) asm volatile("" : "+v"(x))
  #define GAPA(MF, A0, A1, A2, A3, W0, W1, PW) do { MF; sacc += A0; sacc += A1; sacc += A2; sacc += A3; PIN(sacc); W0; W1; PIN(PW); SBAR(); } while (0)
  #define EX(v) __builtin_amdgcn_exp2f(v)
  #define GAPB(MF, X, B) do { MF; X[B] = EX(X[B]); X[B + 1] = EX(X[B + 1]); X[B + 2] = EX(X[B + 2]); X[B + 3] = EX(X[B + 3]); PIN(X); SBAR(); } while (0)
  #define VRD(i) do { vlo[i] = vtr(vp_ + (((i) >> 2) * 4096 + ((i) & 3) * 1024)); vhi[i] = vtr(vp_ + (((i) >> 2) * 4096 + ((i) & 3) * 1024 + 512)); } while (0)
  #define KRD(G_, j) do { if (G_) { kload2(kf, kp0 + sl_next, j); SBAR(); } } while (0)
  #define BRD(G_, P, base, j0) do { if ((G_) && MODE == 0) { BLD(P, base, j0); SBAR(); } } while (0)
  #define STEP(C0, C1, P0, P1, t, GK, GV, GL) do { SBAR(); \
    const lds_cptr vp_ = vp0 + sl_prev; const int bb_ = 16 * ((t) + 1); \
    VRD(0); SBAR(); float sacc = (P0[0] + P0[1]); \
    GAPA(C0 = MFMA32(kf[0], qr[0], CI(C0)), P0[2], P0[3], P0[4], P0[5],     pw0[0] = PKW(P0, 0), pw0[1] = PKW(P0, 2), pw0); \
    VRD(4); SBAR(); GAPA(C1 = MFMA32(kf[1], qr[0], CI(C1)), P0[6], P0[7], P0[8], P0[9],     pw0[2] = PKW(P0, 4), pw0[3] = PKW(P0, 6), pw0); \
    VRD(1); SBAR(); GAPA(C0 = MFMA32(kf[2], qr[1], C0),   P0[10], P0[11], P0[12], P0[13], pw1[0] = PKW(P0, 8), pw1[1] = PKW(P0, 10), pw1); \
    VRD(5); SBAR(); GAPA(C1 = MFMA32(kf[3], qr[1], C1),   P0[14], P0[15], P1[0], P1[1],   pw1[2] = PKW(P0, 12), pw1[3] = PKW(P0, 14), pw1); \
    VRD(2); SBAR(); GAPA(C0 = MFMA32(kf[4], qr[2], C0),   P1[2], P1[3], P1[4], P1[5],     pw2[0] = PKW(P1, 0), pw2[1] = PKW(P1, 2), pw2); \
    VRD(6); SBAR(); GAPA(C1 = MFMA32(kf[5], qr[2], C1),   P1[6], P1[7], P1[8], P1[9],     pw2[2] = PKW(P1, 4), pw2[3] = PKW(P1, 6), pw2); \
    VRD(3); SBAR(); GAPA(C0 = MFMA32(kf[6], qr[3], C0),   P1[10], P1[11], P1[12], P1[13], pw3[0] = PKW(P1, 8), pw3[1] = PKW(P1, 10), pw3); \
    VRD(7); SBAR(); GAPA(C1 = MFMA32(kf[7], qr[3], C1),   P1[14], P1[15], 0.f, 0.f,       pw3[2] = PKW(P1, 12), pw3[3] = PKW(P1, 14), pw3); \
    l_reg += sacc; \
    if (GK) { DMA_K((t) + 3, sl_cur); } if (GV) { DMA_V((t) + 1, sl_next); } \
    CMASK(C0, C1, t); \
    SBAR(); \
    BRD(GL, P0, bb_, 0); GAPB(o[0] = MFMA32(PAF(0), VFR(0), o[0]), C0, 0); \
    BRD(GL, P0, bb_, 2); GAPB(o[1] = MFMA32(PAF(0), VFR(4), o[1]), C0, 4); \
    KRD(GL, 0); GAPB(o[0] = MFMA32(PAF(1), VFR(1), o[0]), C0, 8); \
    KRD(GL, 1); GAPB(o[1] = MFMA32(PAF(1), VFR(5), o[1]), C0, 12); \
    KRD(GL, 2); GAPB(o[0] = MFMA32(PAF(2), VFR(2), o[0]), C1, 0); \
    KRD(GL, 3); GAPB(o[1] = MFMA32(PAF(2), VFR(6), o[1]), C1, 4); \
    BRD(GL, P1, bb_ + 8, 0); GAPB(o[0] = MFMA32(PAF(3), VFR(3), o[0]), C1, 8); \
    BRD(GL, P1, bb_ + 8, 2); GAPB(o[1] = MFMA32(PAF(3), VFR(7), o[1]), C1, 12); \
    } while (0)
  int t = 1;
  #undef CMASK
  #define CMASK(P0, P1, t) do {} while (0)
  for (; t + 5 < NT; t += 2) {
    STEP(pB0, pB1, pA0, pA1, t, true, true, true);     WAIT_BAR(2); ROT();
    STEP(pA0, pA1, pB0, pB1, t + 1, true, true, true); WAIT_BAR(2); ROT();
  }
  #undef CMASK
  #define CMASK(P0, P1, t) do { if (MODE == 1 || (t) >= NT - 4) amask<MODE>(P0, P1, dq - 64 * (t)); } while (0)
  #define ENDW(tt) do { if ((tt) + 3 < NT) { WAIT_BAR(2); } else if ((tt) + 2 < NT) { WAIT_BAR(1); } else { WAIT_BAR(0); } } while (0)
  for (; t + 1 < NT; t += 2) {
    STEP(pB0, pB1, pA0, pA1, t, (t + 3 < NT), (t + 1 < NT), (t + 1 < NT));         ENDW(t);     ROT();
    STEP(pA0, pA1, pB0, pB1, t + 1, (t + 4 < NT), (t + 2 < NT), (t + 2 < NT));     ENDW(t + 1); ROT();
  }
  STEP(pB0, pB1, pA0, pA1, NT - 1, false, false, false);
  u32x4 gv[4];
  { const bf16* Gw0 = G + (rowbase + q0 + rw) * DM + hw * D;
    #pragma unroll
    for (int i = 0; i < 4; ++i) gv[i] = *(const u32x4*)(Gw0 + (long)(i * 8 + (lane >> 3)) * DM + (lane & 7) * 8); }
  if (has_next) {
    const int hwn = MODE ? un.hq + (wid >> 2) : un.hq;
    const bf16* Qn = Q + ((long)un.b * SEQ + un.q0<MODE>() + rw) * DM + hwn * D;
    #pragma unroll
    for (int d0 = 0; d0 < 4; ++d0) qr[d0] = *reinterpret_cast<const bf16x8*>(&Qn[(long)r32 * DM + d0 * 16 + hi * 8]);
  }
  { float sacc = pB0[0] + pB0[1]; _Pragma("unroll") for (int r = 2; r < 16; ++r) sacc += pB0[r]; _Pragma("unroll") for (int r = 0; r < 16; ++r) sacc += pB1[r]; l_reg += sacc;
    pw0 = (u32x4){PKW(pB0, 0), PKW(pB0, 2), PKW(pB0, 4), PKW(pB0, 6)}; pw1 = (u32x4){PKW(pB0, 8), PKW(pB0, 10), PKW(pB0, 12), PKW(pB0, 14)}; pw2 = (u32x4){PKW(pB1, 0), PKW(pB1, 2), PKW(pB1, 4), PKW(pB1, 6)}; pw3 = (u32x4){PKW(pB1, 8), PKW(pB1, 10), PKW(pB1, 12), PKW(pB1, 14)};
    SBAR(); pv(o, vb0 + sl_cur, PAF(0), PAF(1), PAF(2), PAF(3)); }
  asm volatile("s_waitcnt lgkmcnt(0)\n\ts_barrier" ::: "memory");
  if (has_next) {
    if (MODE == 0) bias_table(ctab, shm, un.q0<MODE>() + QROWS, tid);
    const bf16* Khn = K + ((long)un.b * SEQ + (long)un.T0<MODE>() * KVBLK) * KP + un.kvh<MODE>() * D, *Vhn = V + ((long)un.b * SEQ + (long)un.T0<MODE>() * KVBLK) * KP + un.kvh<MODE>() * D;
    glds16(Khn, koff, (unsigned)__builtin_amdgcn_readfirstlane(kdst)); glds16(Vhn, voff, (unsigned)__builtin_amdgcn_readfirstlane(vdst));
    glds16(Khn + (long)KVBLK * KP, koff, (unsigned)__builtin_amdgcn_readfirstlane(kdst + SLOTB)); glds16(Khn + 2L * KVBLK * KP, koff, (unsigned)__builtin_amdgcn_readfirstlane(kdst + 2 * SLOTB));
  }
  #undef PKW
  #undef PAF
  #undef VFR
  #undef PIN
  #undef GAPA
  #undef GAPB
  #undef EX
  #undef VRD
  #undef KRD
  #undef BRD
  #undef STEP
  #undef ENDW
  { auto rr = __builtin_amdgcn_permlane32_swap(__float_as_uint(l_reg), __float_as_uint(l_reg), false, false); l_reg = __uint_as_float(rr[0]) + __uint_as_float(rr[1]); }
  if (MODE == 1) l_reg += __builtin_amdgcn_exp2f(sinks[hw] * 1.4426950408889634f);
  int lane_e = lane; asm volatile("" : "+v"(lane_e));
  const int r32e = lane_e & 31, hie = lane_e >> 5;
  float* wsfe = (float*)(shm + LDS_WS) + wid * 64;
  if (hie == 0) wsfe[32 + r32e] = l_reg; asm volatile("s_waitcnt lgkmcnt(0)" ::: "memory");
  float rli[16];
  #pragma unroll
  for (int r = 0; r < 16; ++r) rli[r] = __builtin_amdgcn_rcpf(wsfe[32 + crow(r, hie)]);
  bf16* Ow = O + (rowbase + q0 + rw) * DM + hw * D;
  { float* stg = (float*)(shm + LDS_OST) + wid * 2048;
    #pragma unroll
    for (int r = 0; r < 16; ++r) { const int orow = crow(r, hie);
      #pragma unroll
      for (int d0 = 0; d0 < 2; ++d0) stg[orow * 64 + d0 * 32 + r32e] = o[d0][r] * rli[r]; }
    asm volatile("s_waitcnt lgkmcnt(0)" ::: "memory");
    #pragma unroll
    for (int i = 0; i < 4; ++i) { const int row = i * 8 + (lane_e >> 3), ch = lane_e & 7;
      const f32x4 a0 = *(const f32x4*)(stg + row * 64 + ch * 8), a1 = *(const f32x4*)(stg + row * 64 + ch * 8 + 4);
      u32x4 w;
      w.x = cvtpk_s(a0[0] * __uint_as_float(gv[i].x << 16), a0[1] * __uint_as_float(gv[i].x & 0xffff0000u));
      w.y = cvtpk_s(a0[2] * __uint_as_float(gv[i].y << 16), a0[3] * __uint_as_float(gv[i].y & 0xffff0000u));
      w.z = cvtpk_s(a1[0] * __uint_as_float(gv[i].z << 16), a1[1] * __uint_as_float(gv[i].z & 0xffff0000u));
      w.w = cvtpk_s(a1[2] * __uint_as_float(gv[i].w << 16), a1[3] * __uint_as_float(gv[i].w & 0xffff0000u));
      *(u32x4*)(Ow + (long)row * DM + ch * 8) = w; } }
  #undef DMA_K
  #undef DMA_V
  #undef CMASK
  #undef MFMA32
  #undef CI
  #undef BLD
  #undef ROT
}
constexpr int ATTN_LDS_BYTES = LDS_BYTES;
#undef SBAR
#undef WAIT_BAR
}

constexpr int NWAVES = 8;
constexpr size_t WS_DUMMY = 184 * MiB;
constexpr int N_PHASES = 7;
constexpr size_t CTL_ZERO_BYTES = 1 * MiB;
constexpr int CW_BAR = 4096;
constexpr int RING_OFF = 0, RING_BYTES = 131072;
constexpr int LDSCTL_OFF = RING_BYTES, MISC_OFF = LDSCTL_OFF + 320;
constexpr int XCH_OFF = RING_BYTES + 1024;
constexpr int LDS_BYTES = 147456;
static_assert(XCH_OFF + 8192 <= LDS_BYTES && MISC_OFF + 128 <= XCH_OFF, "LDS map");

#define GAS __attribute__((address_space(1)))
#define LAS __attribute__((address_space(3)))
typedef unsigned v4u __attribute__((ext_vector_type(4)));
typedef GAS unsigned gu32;
#define RLX_AGENT __ATOMIC_RELAXED, __HIP_MEMORY_SCOPE_AGENT
#define LDS_WAIT() asm volatile("s_waitcnt lgkmcnt(0)" ::: "memory")
#define VM_WAIT() asm volatile("s_waitcnt vmcnt(0)" ::: "memory")
__device__ __forceinline__ unsigned pk2(float lo, float hi) { return f2bf(lo) | (f2bf(hi) << 16); }

#define XB_TMO      128
#define XB_XCNT(j)  (256  + 64 * (j))
#define XB_XSUB(j)  (1280 + 64 * (j))
#define XB_XGEN(j)  (2304 + 64 * (j))
#define XB_TOP      3328
#define XB_TOPGEN   3392
#define XCD_BAR_WORDS 3456
#define XB_SPIN_CAP (1u << 18)

__device__ __forceinline__ unsigned xb_ld(unsigned* p)              { return __hip_atomic_load(p, __ATOMIC_RELAXED, __HIP_MEMORY_SCOPE_AGENT); }
__device__ __forceinline__ unsigned xb_add(unsigned* p, unsigned v) { return __hip_atomic_fetch_add(p, v, __ATOMIC_RELAXED, __HIP_MEMORY_SCOPE_AGENT); }
__device__ __forceinline__ unsigned xb_xcc_id() { return (unsigned)__builtin_amdgcn_s_getreg((3 << 11) | 20) & 0xFu; }
#define XB_SPIN(cond, bar) do { unsigned _sp = 0; while (cond) { __builtin_amdgcn_s_sleep(1); \
    if ((++_sp & 255u) == 0u) { if (xb_ld(&(bar)[XB_TMO])) break; if (_sp > XB_SPIN_CAP) { atomicAdd(&(bar)[XB_TMO], 1u); break; } } } } while (0)

struct XcdBarrier {
    unsigned* bar; unsigned x;
    volatile LAS unsigned* st;
};

__device__ __forceinline__ XcdBarrier xcd_barrier_post(unsigned* bar, volatile LAS unsigned* st) {
    XcdBarrier b; b.bar = bar; b.x = xb_xcc_id(); b.st = st;
    if (threadIdx.x == 0) (void)xb_add(&bar[XB_XCNT(b.x)], 1u);
    return b;
}
__device__ __forceinline__ void xcd_barrier_complete(unsigned* bar, unsigned x, unsigned& nloc, unsigned& nx) {
    const unsigned G = gridDim.x * gridDim.y * gridDim.z;
    unsigned sum, cnt, mine, sp = 0u;
    for (;;) {
        sum = 0u; cnt = 0u; mine = 0u;
#pragma unroll
        for (unsigned j = 0; j < 16; ++j) { const unsigned c = xb_ld(&bar[XB_XCNT(j)]); sum += c; cnt += (c > 0u) ? 1u : 0u; mine = (j == x) ? c : mine; }
        if (sum == G) break;
        __builtin_amdgcn_s_sleep(1);
        if ((++sp & 255u) == 0u) { if (xb_ld(&bar[XB_TMO])) break; if (sp > XB_SPIN_CAP) { atomicAdd(&bar[XB_TMO], 1u); break; } }
    }
    nloc = mine > 0u ? mine : 1u; nx = cnt > 0u ? cnt : 1u;
}

__device__ __forceinline__ void xcd_barrier(const XcdBarrier& b) {
    asm volatile("s_waitcnt vmcnt(0)" ::: "memory");
    __syncthreads();
    if (threadIdx.x == 0) {
        unsigned* bar = b.bar;
        __builtin_amdgcn_s_waitcnt(0);
        unsigned nloc = b.st[0], nx = b.st[1];
        if (nloc == 0u) { xcd_barrier_complete(bar, b.x, nloc, nx); b.st[0] = nloc; b.st[1] = nx; }
        const unsigned old = xb_add(&bar[XB_XSUB(b.x)], 1u);
        const unsigned gen = old / nloc;
        if (old + 1u == (gen + 1u) * nloc) {
            __builtin_amdgcn_fence(__ATOMIC_RELEASE, "agent");
            asm volatile("s_waitcnt vmcnt(0)" ::: "memory");
            const unsigned og = xb_add(&bar[XB_TOP], 1u);
            const unsigned tg = og / nx;
            if (og + 1u == (tg + 1u) * nx) xb_add(&bar[XB_TOPGEN], 1u);
            else XB_SPIN(xb_ld(&bar[XB_TOPGEN]) == tg, bar);
            __builtin_amdgcn_fence(__ATOMIC_ACQUIRE, "agent");
            xb_add(&bar[XB_XGEN(b.x)], 1u);
            asm volatile("s_waitcnt vmcnt(0)" ::: "memory");
        } else {
            XB_SPIN(xb_ld(&bar[XB_XGEN(b.x)]) == gen, bar);
            __builtin_amdgcn_fence(__ATOMIC_ACQUIRE, "agent");
            asm volatile("s_waitcnt vmcnt(0)" ::: "memory");
        }
    }
    __syncthreads();
}

struct Frame {
    LAS unsigned char* lds;
    volatile LAS unsigned* MISC;
    gu32* ctl;
    int tid, lane, wave;
    int vcu, G;
};

__device__ __forceinline__ void p0_transpose_item(const float* W, int ldw, int col0, const float* gain, bf16_t* WT, LAS float* scr, int k0, int lane) {
    float w[32];
#pragma unroll
    for (int i = 0; i < 32; ++i) w[i] = W[(size_t)(k0 + 2 * i + (lane >> 5)) * ldw + col0 + (lane & 31)];
    const int c = lane & 7;
    f32x4 g0 = {1.f, 1.f, 1.f, 1.f}, g1 = g0;
    if (gain) { g0 = *(const f32x4*)(gain + k0 + 8 * c); g1 = *(const f32x4*)(gain + k0 + 8 * c + 4); }
#pragma unroll
    for (int i = 0; i < 32; ++i) { const int kk = 2 * i + (lane >> 5); scr[kk * 32 + ((lane & 31) ^ (((kk >> 3) & 7) << 2))] = w[i]; }
    LDS_WAIT(); asm volatile("" ::: "memory");
#pragma unroll
    for (int j = 0; j < 4; ++j) { const int n = (lane >> 3) + 8 * j; const LAS float* s = scr + (8 * c) * 32 + (n ^ (c << 2));
        v4u o; o.x = pk2(s[0 * 32] * g0[0], s[1 * 32] * g0[1]); o.y = pk2(s[2 * 32] * g0[2], s[3 * 32] * g0[3]); o.z = pk2(s[4 * 32] * g1[0], s[5 * 32] * g1[1]); o.w = pk2(s[6 * 32] * g1[2], s[7 * 32] * g1[3]);
        *(GAS v4u*)(WT + (size_t)n * 1024 + k0 + 8 * c) = o; }
    LDS_WAIT(); asm volatile("" ::: "memory");
}
__device__ __forceinline__ void p0_rows4(Frame& F, const P& p, int m0, const LAS float* WFl) {
    bf16_t* XB = (bf16_t*)(p.ws + WS_XB); float* RS0 = (float*)(p.ws + WS_RS0); float* LF = (float*)(p.ws + WS_LF);
    const int lane = F.lane;
    f32x4 v[4][4]; float rstd[4];
#pragma unroll
    for (int r = 0; r < 4; ++r) { const f32x4* xr = (const f32x4*)(p.x + (size_t)(m0 + r) * 1024) + lane; float ss = 0.f;
#pragma unroll
        for (int j = 0; j < 4; ++j) { v[r][j] = xr[64 * j]; ss += (v[r][j][0] * v[r][j][0] + v[r][j][1] * v[r][j][1]) + (v[r][j][2] * v[r][j][2] + v[r][j][3] * v[r][j][3]); }
        ss = wave_sum(ss); rstd[r] = 1.0f / sqrtf(ss * (1.0f / 1024.0f) + EPS); }
#pragma unroll
    for (int r = 0; r < 4; ++r)
#pragma unroll
        for (int j = 0; j < 4; ++j) { uint2 o; o.x = pk2(v[r][j][0], v[r][j][1]); o.y = pk2(v[r][j][2], v[r][j][3]); *(uint2*)(XB + (size_t)(m0 + r) * 1024 + 4 * (lane + 64 * j)) = o; }
    float a[64];
#pragma unroll
    for (int i = 0; i < 64; ++i) a[i] = 0.f;
#pragma unroll
    for (int h = 0; h < 16; ++h)
#pragma unroll
        for (int j = 0; j < 4; ++j) { const f32x4 w = *(const LAS f32x4*)(WFl + h * 1024 + 4 * (lane + 64 * j));
#pragma unroll
            for (int r = 0; r < 4; ++r) a[r * 16 + h] += (v[r][j][0] * w[0] + v[r][j][1] * w[1]) + (v[r][j][2] * w[2] + v[r][j][3] * w[3]);
            if (j == 3) asm volatile("" ::: "memory"); }
#define TR_STEP(OFF) { const bool up = (lane & OFF) != 0; _Pragma("unroll") for (int i = 0; i < OFF; ++i) { const float keep = up ? a[i + OFF] : a[i]; const float send = up ? a[i] : a[i + OFF]; a[i] = keep + __shfl_xor(send, OFF); } }
    TR_STEP(32) TR_STEP(16) TR_STEP(8) TR_STEP(4) TR_STEP(2) TR_STEP(1)
#undef TR_STEP
    const int rsel = lane >> 4, h = lane & 15;
    const float rsd = rsel == 0 ? rstd[0] : rsel == 1 ? rstd[1] : rsel == 2 ? rstd[2] : rstd[3];
    const float z = a[0] * rsd + p.b_forget[h];
    const float lf = fminf(z, 0.f) - log1pf(expf(-fabsf(z)));
    const int row = m0 + rsel, b = row / SEQ, s = row % SEQ;
    LF[((size_t)b * 16 + h) * SEQ + s] = lf;
    if (lane < 4) RS0[m0 + lane] = lane == 0 ? rstd[0] : lane == 1 ? rstd[1] : lane == 2 ? rstd[2] : rstd[3];
}
__device__ __forceinline__ void p0_prologue(Frame& F, const P& p) {
    LAS float* scr = (LAS float*)(F.lds + RING_OFF + F.wave * 8192);
    LAS float* WFl = (LAS float*)(F.lds + RING_OFF + 65536);
    const int gw = F.vcu * NWAVES + F.wave, NGW = F.G * NWAVES;
    { float wv[32], gv[32];
#pragma unroll
      for (int i = 0; i < 32; ++i) { const int e = F.tid + i * (NWAVES * 64), k = e >> 4, h = e & 15; wv[i] = p.w_in_a[(size_t)k * WINA + 3072 + h]; gv[i] = p.norm_a_g[k]; }
#pragma unroll
      for (int i = 0; i < 32; ++i) { const int e = F.tid + i * (NWAVES * 64), k = e >> 4, h = e & 15; WFl[h * 1024 + k] = gv[i] * wv[i]; } }
    __syncthreads();
    for (int rg = gw; rg < M / 4; rg += NGW) p0_rows4(F, p, rg * 4, WFl);
    constexpr int I_A = 16 * 128;
    for (int it = gw; it < I_A; it += NGW) { const int kb = it / 128, n0 = 32 * (it % 128); p0_transpose_item(p.w_in_a, WINA, n0 + (n0 >= 3072 ? 16 : 0), p.norm_a_g, (bf16_t*)(p.ws + WS_WTA) + (size_t)n0 * 1024, scr, 64 * kb, F.lane); }
    { const int gt = (F.G - 1 - F.vcu) * (NWAVES * 64) + F.tid;
      if (gt < 2048 * 8) { float* ROPE = (float*)(p.ws + WS_ROPE); const int s = gt >> 3, f = gt & 7; double sn, cs; sincos_d((double)p.positions[s] * p.invf[f], sn, cs); ROPE[gt] = (float)cs; ROPE[2048 * 8 + gt] = (float)sn; } }
    __syncthreads();
}
__device__ __forceinline__ void p2_scan(Frame& F, const P& p, int bh, LAS float* ctab, LAS double* wsum) {
    const float* LF = (const float*)(p.ws + WS_LF);
    const f32x4 v = *(const f32x4*)(LF + (size_t)bh * SEQ + F.tid * 4);
    const double l0 = (double)v[0], l1 = l0 + (double)v[1], l2 = l1 + (double)v[2], l3 = l2 + (double)v[3]; double incl = l3;
#pragma unroll
    for (int o = 1; o < 64; o <<= 1) { const double t = __shfl_up(incl, o); if (F.lane >= o) incl += t; }
    if (F.lane == 63) wsum[F.wave] = incl;
    __syncthreads();
    double base = 0.0;
#pragma unroll
    for (int w = 0; w < NWAVES; ++w) { const double t = wsum[w]; if (w < F.wave) base += t; }
    const double excl = base + incl - l3, L2E = 1.4426950408889634;
    *(LAS f32x4*)(ctab + F.tid * 4) = (f32x4){(float)((excl + l0) * L2E), (float)((excl + l1) * L2E), (float)((excl + l2) * L2E), (float)((excl + l3) * L2E)};
    __syncthreads();
}
__device__ __forceinline__ void p2_late_weights(Frame& F, const P& p, LAS float* scr) {
    bf16_t* WTOA = (bf16_t*)(p.ws + WS_WTOA); bf16_t* WTB = (bf16_t*)(p.ws + WS_WTB); bf16_t* WTOB = (bf16_t*)(p.ws + WS_WTOB);
    const int gw = F.vcu * NWAVES + F.wave, NGW = F.G * NWAVES;
    constexpr int I_OA = 16 * 32, I_KV = 16 * 16, I_B = 16 * 64, I_OB = 16 * 32, NITEMS = I_OA + I_KV + I_B + I_OB;
    for (int it = gw; it < NITEMS; it += NGW) {
        int r = it;
        if (r < I_OA) { const int kb = r / 32, n0 = 32 * (r % 32); p0_transpose_item(p.w_out_a, 1024, n0, nullptr, WTOA + (size_t)n0 * 1024, scr, 64 * kb, F.lane); continue; } r -= I_OA;
        if (r < I_KV) { const int kb = r / 16, n0 = 32 * (r % 16); p0_transpose_item(p.w_kv, 512, n0, p.kv_norm_g, WTB + (size_t)n0 * 1024, scr, 64 * kb, F.lane); continue; } r -= I_KV;
        if (r < I_B) { const int kb = r / 64, n0 = 32 * (r % 64); p0_transpose_item(p.w_in_b, 2048, n0, p.norm_b_g, WTB + (size_t)(512 + n0) * 1024, scr, 64 * kb, F.lane); continue; } r -= I_B;
        { const int kb = r / 32, n0 = 32 * (r % 32); p0_transpose_item(p.w_out_b, 1024, n0, nullptr, WTOB + (size_t)n0 * 1024, scr, 64 * kb, F.lane); }
    }
}
template <int MODE> __device__ __forceinline__ attn_body::AUnit attn_unit_of(int pv, int i) {
    attn_body::AUnit u;
    if (MODE == 0) { const int bh = pv >> 1, s = pv & 1; u.b = bh >> 4; u.hq = bh & 15; u.qb = (i == 0) ? s : (i == 1) ? 3 - s : (i == 2) ? 4 + s : 7 - s; }
    else { const int j = pv & 7, kvh = (pv >> 3) & 3; u.b = pv >> 5; u.hq = kvh * 4 + (i & 1) * 2; u.qb = 2 * j + (i >> 1); }
    return u;
}
template <int MODE> __device__ __forceinline__ void attn_phase(Frame& F, const P& p, char* lds, bool dry) {
    static_assert(WS_Q0 == 56 * MiB && WS_K0 == 88 * MiB && WS_V0 == 120 * MiB && WS_G0 == 152 * MiB && WS_DUMMY == 184 * MiB, "attn_body::attn_ptrs hard-codes the d_ws map");
    LAS float* ctab = (LAS float*)(F.lds + XCH_OFF);
    attn_body::bf16x8 qr[4];
    const int pv = F.vcu;
    if (pv < 256) {
        if (MODE == 0) p2_late_weights(F, p, (LAS float*)(F.lds + RING_OFF + attn_body::LDS_OST + F.wave * 8192));
        attn_body::attn_start<MODE>(attn_unit_of<MODE>(pv, 0), qr, p.ws, lds);
        if (MODE == 0) {
            p2_scan(F, p, pv >> 1, ctab, (LAS double*)(F.lds + RING_OFF + attn_body::LDS_WS));
            attn_body::bias_table(ctab, lds, 256 * attn_unit_of<MODE>(pv, 0).qb + 256, F.tid);
        }
#pragma unroll 1
        for (int i = 0; i < 4; ++i) attn_body::attn_unit<MODE>(attn_unit_of<MODE>(pv, i), attn_unit_of<MODE>(pv, i + 1), i < 3, dry, qr, p.ws, ctab, p.sinks, lds);
    }
}

#ifndef PROBE_PHASE
#define PROBE_PHASE (-1)
#endif
#ifndef PROBE_REPS
#define PROBE_REPS 0
#endif
#define REPLOOP(k) for (int rep_ = (PROBE_PHASE == (k)) ? -(PROBE_REPS) : 0; rep_ <= 0; ++rep_)
#define DRY (rep_ < 0)
#define REPSEAM(k) do { if (DRY) xcd_barrier(bar); else SEAM(k); } while (0)
struct Args { P p; int ph_lo, ph_hi, li, pad; };
__global__ void __launch_bounds__(NWAVES * 64, 2) mk_fwd(Args args) {
    extern __shared__ __attribute__((aligned(16))) unsigned char lds[];
    const P& p = args.p;
    Frame F;
    F.lds = (LAS unsigned char*)lds;
    F.MISC = (volatile LAS unsigned*)(F.lds + MISC_OFF);
    F.tid = threadIdx.x; F.lane = F.tid & 63; F.wave = __builtin_amdgcn_readfirstlane(F.tid >> 6);
    F.G = gridDim.x; { const int bx = blockIdx.x; F.vcu = (F.G % 8 == 0) ? (bx % 8) * (F.G / 8) + bx / 8 : bx; }
    F.ctl = (gu32*)(p.ws + WS_CTL);
    for (int u = F.tid; u < (XCH_OFF - LDSCTL_OFF) / 4; u += NWAVES * 64) ((LAS unsigned*)(F.lds + LDSCTL_OFF))[u] = 0u;
    __syncthreads();
    const int lo = args.ph_lo, hi = args.ph_hi;
    XcdBarrier bar; bar.bar = (unsigned*)(F.ctl + CW_BAR) + args.li * XCD_BAR_WORDS; bar.x = 0; bar.st = nullptr;
    if (hi - lo > 1 || PROBE_REPS > 0) bar = xcd_barrier_post((unsigned*)(F.ctl + CW_BAR) + args.li * XCD_BAR_WORDS, F.MISC + 8);
#ifndef PHASE_MASK
#define PHASE_MASK 127
#endif
#define IN(k) (((PHASE_MASK >> (k)) & 1) && lo <= (k) && (k) < hi)
#define SEAM(k) do { if (IN(k) && IN((k) + 1)) xcd_barrier(bar); } while (0)
    PG8_LAS float* xch = (PG8_LAS float*)(F.lds + XCH_OFF);

    if (IN(0)) REPLOOP(0) { p0_prologue(F, p); REPSEAM(0); }

    if (IN(1)) REPLOOP(1) {
        pg8::Gemm g{(const pg8::bf16_t*)(p.ws + WS_XB), (const pg8::bf16_t*)(p.ws + WS_WTA), M, NA, 1024}; pg8::StaticOrder S; S.init(M, NA, F.G, (int)blockIdx.x);
        pg8::EpiProj<0> E{(const float*)(p.ws + WS_RS0), p.qnorm_a_g, p.knorm_a_g, nullptr, (pg8::bf16_t*)(p.ws + WS_Q0), xch};
        pg8::gemm_phase<pg8::EpiProj<0>, pg8::StaticOrder, true, true>(F.lds + RING_OFF, g, S, E);
        REPSEAM(1);
    }
    if (IN(2)) { static_assert(attn_body::ATTN_LDS_BYTES <= RING_BYTES, "attention body geometry vs frame"); REPLOOP(2) { attn_phase<0>(F, p, (char*)lds + RING_OFF, DRY); REPSEAM(2); } }
    if (IN(3)) REPLOOP(3) {
        pg8::Gemm g{(const pg8::bf16_t*)(p.ws + WS_Q0), (const pg8::bf16_t*)(p.ws + WS_WTOA), M, 1024, 1024}; pg8::StaticOrder S; S.init(M, 1024, F.G, (int)blockIdx.x);
        pg8::EpiRes1 E{p.x, p.out, (pg8::bf16_t*)(p.ws + WS_XB), (float*)(p.ws + WS_SS1)};
        pg8::gemm_phase<pg8::EpiRes1, pg8::StaticOrder, false, true>(F.lds + RING_OFF, g, S, E);
        REPSEAM(3);
    }
    if (IN(4)) REPLOOP(4) {
        pg8::Gemm g{(const pg8::bf16_t*)(p.ws + WS_XB), (const pg8::bf16_t*)(p.ws + WS_WTB), M, NB, 1024}; pg8::StaticOrder S; S.init(M, NB, F.G, (int)blockIdx.x);
        pg8::EpiProj<1> E{(const float*)(p.ws + WS_SS1), p.qnorm_b_g, p.knorm_b_g, (const float*)(p.ws + WS_ROPE), (pg8::bf16_t*)(p.ws + WS_K0), xch};
        static_assert(WS_K0 - WS_Q0 == 32 * MiB && WS_V0 - WS_K0 == 32 * MiB && WS_G0 - WS_V0 == 32 * MiB, "EpiProj's output offsets");
        pg8::gemm_phase<pg8::EpiProj<1>, pg8::StaticOrder, true, true>(F.lds + RING_OFF, g, S, E);
        REPSEAM(4);
    }
    if (IN(5)) REPLOOP(5) { attn_phase<1>(F, p, (char*)lds + RING_OFF, DRY); REPSEAM(5); }
    if (IN(6)) REPLOOP(6) {
        pg8::Gemm g{(const pg8::bf16_t*)(p.ws + WS_K0), (const pg8::bf16_t*)(p.ws + WS_WTOB), M, 1024, 1024}; pg8::StaticOrder S; S.init(M, 1024, F.G, (int)blockIdx.x);
        pg8::EpiRes2 E{DRY ? (float*)(p.ws + WS_DUMMY) : p.out};
        pg8::gemm_phase<pg8::EpiRes2, pg8::StaticOrder, false, true>(F.lds + RING_OFF, g, S, E);
        if (DRY) xcd_barrier(bar);
    }
#undef IN
#undef SEAM
}

#ifndef MK_CUTS
#define MK_CUTS 0
#endif
#ifndef NAIVE_MASK
#define NAIVE_MASK 0
#endif
extern "C" void kernel_launch(void* const* d_in, const int* in_sizes, int n_in, void* d_out, int out_size, void* d_ws, size_t ws_size, hipStream_t stream) {
    static int grid = 0;
    if (grid == 0) {
        if (n_in != 16 || out_size != M * DM || ws_size < WS_DUMMY + 64 * MiB) { fprintf(stderr, "kernel_launch: unexpected shapes (n_in %d out %d ws %zu); nothing launched\n", n_in, out_size, ws_size); grid = -1; return; }
        int dev = 0, cus = 0, per_cu = 0;
        if (hipGetDevice(&dev) != hipSuccess || hipDeviceGetAttribute(&cus, hipDeviceAttributeMultiprocessorCount, dev) != hipSuccess) { fprintf(stderr, "kernel_launch: hipGetDevice / hipDeviceGetAttribute failed\n"); grid = -1; return; }
        if (hipFuncSetAttribute((const void*)mk_fwd, hipFuncAttributeMaxDynamicSharedMemorySize, LDS_BYTES) != hipSuccess) { fprintf(stderr, "kernel_launch: hipFuncSetAttribute failed\n"); grid = -1; return; }
        if (hipOccupancyMaxActiveBlocksPerMultiprocessor(&per_cu, (const void*)mk_fwd, NWAVES * 64, LDS_BYTES) != hipSuccess || per_cu < 1)
            fprintf(stderr, "kernel_launch: note: the occupancy query reports %d workgroups per CU\n", per_cu);
        (void)hipGetLastError();
        grid = cus;
        if (grid != 256) { fprintf(stderr, "kernel_launch: %d CUs; this kernel is built for exactly 256 (one workgroup per CU; one 256x256 unit per workgroup in the out-projection phases, one attention stream per workgroup); nothing launched\n", grid); grid = -1; return; }
    }
    if (grid < 0) return;
    if (hipMemsetAsync((char*)d_ws + WS_CTL, 0, CTL_ZERO_BYTES, stream) != hipSuccess) { fprintf(stderr, "kernel_launch: hipMemsetAsync of the control words failed\n"); return; }
    Args a{};
    P& p = a.p;
    p.x = (const float*)d_in[0]; p.positions = (const int*)d_in[1]; p.norm_a_g = (const float*)d_in[2]; p.w_in_a = (const float*)d_in[3]; p.b_forget = (const float*)d_in[4];
    p.qnorm_a_g = (const float*)d_in[5]; p.knorm_a_g = (const float*)d_in[6]; p.w_out_a = (const float*)d_in[7]; p.kv_norm_g = (const float*)d_in[8]; p.w_kv = (const float*)d_in[9];
    p.knorm_b_g = (const float*)d_in[10]; p.norm_b_g = (const float*)d_in[11]; p.w_in_b = (const float*)d_in[12]; p.qnorm_b_g = (const float*)d_in[13]; p.sinks = (const float*)d_in[14];
    p.w_out_b = (const float*)d_in[15]; p.out = (float*)d_out; p.ws = (unsigned char*)d_ws;
    for (int i = 0; i < 8; ++i) p.invf[i] = std::pow(500000.0, -(double)i / 8.0);
    int lo = 0, li = 0;
    for (int ph = 0; ph < N_PHASES; ++ph) {
        const bool naive = (NAIVE_MASK >> ph) & 1;
        if (naive) {
            switch (ph) {
                case 0: k_prep_weights<<<2048, 256, 0, stream>>>(p); k_prep_x<<<M / 4, 256, 0, stream>>>(p); break;
                case 1: k_gemm_naive<0><<<dim3(NA / 64, M / 64), 256, 0, stream>>>(p); break;
                case 2: k_prep_weights<<<2048, 256, 0, stream>>>(p); k_scan<<<BATCH * NH, 256, 0, stream>>>(p); k_attn_naive<0><<<dim3(SEQ / 64, BATCH * NH), 256, 0, stream>>>(p); break;
                case 3: k_gemm_naive<1><<<dim3(1024 / 64, M / 64), 256, 0, stream>>>(p); k_rowstat<<<M / 4, 256, 0, stream>>>(p); break;
                case 4: k_gemm_naive<2><<<dim3(NB / 64, M / 64), 256, 0, stream>>>(p); break;
                case 5: k_attn_naive<1><<<dim3(SEQ / 64, BATCH * NH), 256, 0, stream>>>(p); break;
                default: k_gemm_naive<3><<<dim3(1024 / 64, M / 64), 256, 0, stream>>>(p); break;
            }
            lo = ph + 1; continue;
        }
        const bool cut_after = (ph == N_PHASES - 1) || ((MK_CUTS >> ph) & 1) || ((NAIVE_MASK >> (ph + 1)) & 1);
        if (cut_after) {
            a.ph_lo = lo; a.ph_hi = ph + 1; a.li = li++;
            hipLaunchKernelGGL(mk_fwd, dim3(grid), dim3(NWAVES * 64), LDS_BYTES, stream, a);
            const hipError_t le = hipPeekAtLastError();
            if (le != hipSuccess) { fprintf(stderr, "kernel_launch: launch of phases [%d,%d) failed: %s\n", lo, ph + 1, hipGetErrorName(le)); break; }
            lo = ph + 1;
        }
    }
}
```
